# Optimizing an MI355X kernel written in HIP

```python
import math, functools
import jax, jax.numpy as jnp
from jax import lax
import numpy as np

D_MODEL = 1024
BATCH = 4
SEQ = 4096
DEPTH = 1
DEC_BATCH = 128
DEC_SEQ = 8
PAST_LEN = 2048
PAGE_SIZE = 128

SB_HEADS = 8
SB_HEAD_DIM = 64
SB_WIDTH = SB_HEADS * SB_HEAD_DIM
SB_BIAS_INIT = -6.0
SSM_GROUP = 16
SSM_WIDTH = D_MODEL // 2
SSM_GROUPS = SSM_WIDTH // SSM_GROUP
SSM_STATE = 64
D_FF = 2816
Q_BLOCK = 128
ADA_CHUNKS = 9
RMS_EPS = 1e-6
DT_MIN = 1e-3
DT_MAX = 1e-1
IN_SPLITS = (SB_WIDTH, 2 * SB_WIDTH, 3 * SB_WIDTH, 3 * SB_WIDTH + SSM_WIDTH,
             3 * SB_WIDTH + SSM_WIDTH + D_MODEL)
IN_WIDTH = 3 * SB_WIDTH + SSM_WIDTH + 2 * D_MODEL

kernel_name = 'stickbreak_s5_macaron_adaln_step'


def rmsnorm(x, gain):
    xf = x.astype(jnp.float32)
    n = xf * lax.rsqrt(jnp.mean(xf * xf, axis=-1, keepdims=True) + RMS_EPS)
    return (n * gain.astype(jnp.float32)).astype(x.dtype)


def rms_modulate(x, gain, shift, scale):
    xf = x.astype(jnp.float32)
    n = xf * lax.rsqrt(jnp.mean(xf * xf, axis=-1, keepdims=True) + RMS_EPS) * gain.astype(jnp.float32)
    n = n * (1.0 + scale[:, None, :].astype(jnp.float32)) + shift[:, None, :].astype(jnp.float32)
    return n.astype(x.dtype)


def swiglu(u, w_in, w_out):
    g, up = jnp.split(u @ w_in, 2, axis=-1)
    return (jax.nn.silu(g) * up) @ w_out


def stick_breaking(q, k, v, bias, q_pos, k_pos):
    z = (jnp.einsum('bqhd,bkhd->bhqk', q, k).astype(jnp.float32) * (SB_HEAD_DIM ** -0.5)
         + bias.astype(jnp.float32)[None, :, None, None])
    mask = k_pos[None, :] < q_pos[:, None]
    log_beta = jax.nn.log_sigmoid(z)
    log_keep = jnp.where(mask, log_beta - z, 0.0)
    after = lax.cumsum(log_keep, axis=3, reverse=True) - log_keep
    w = jnp.where(mask, jnp.exp(log_beta + after), 0.0)
    return jnp.einsum('bhqk,bkhd->bqhd', w.astype(v.dtype), v)


def sb_prompt(q, k, v, bias):
    b, s, h, d = q.shape
    nblk = s // Q_BLOCK
    qb = q.reshape(b, nblk, Q_BLOCK, h, d).transpose(1, 0, 2, 3, 4)
    k_pos = jnp.arange(s)

    def one_block(args):
        q_blk, i = args
        q_pos = i * Q_BLOCK + jnp.arange(Q_BLOCK)
        return stick_breaking(q_blk, k, v, bias, q_pos, k_pos)

    out = lax.map(one_block, (qb, jnp.arange(nblk)))
    return out.transpose(1, 0, 2, 3, 4).reshape(b, s, h, d)


def sb_sample(q, k, v, bias, past_k, past_v):
    past = past_k.shape[1]
    t = q.shape[1]
    k_all = jnp.concatenate([past_k, k], axis=1)
    v_all = jnp.concatenate([past_v, v], axis=1)
    return stick_breaking(q, k_all, v_all, bias, past + jnp.arange(t), jnp.arange(past + t))


def s5_ssm(u, lam_re, lam_im, log_dt, b_re, b_im, c_re, c_im, d_skip, s0_re, s0_im):
    f32 = jnp.float32
    bsz, L, _ = u.shape
    uf = u.astype(f32)
    ug = uf.reshape(bsz, L, SSM_GROUPS, SSM_GROUP)
    lr, li = lam_re.astype(f32), lam_im.astype(f32)
    dt = jnp.exp(log_dt.astype(f32))[:, None]
    mag = jnp.exp(lr * dt)
    ab_re, ab_im = mag * jnp.cos(li * dt), mag * jnp.sin(li * dt)
    den = lr * lr + li * li
    nr, ni = ab_re - 1.0, ab_im
    zr, zi = (nr * lr + ni * li) / den, (ni * lr - nr * li) / den
    br, bi = b_re.astype(f32), b_im.astype(f32)
    bb_re = zr[..., None] * br - zi[..., None] * bi
    bb_im = zr[..., None] * bi + zi[..., None] * br
    bu_re = jnp.einsum('blgh,gph->blgp', ug, bb_re)
    bu_im = jnp.einsum('blgh,gph->blgp', ug, bb_im)
    s0r, s0i = s0_re.astype(f32), s0_im.astype(f32)
    bu_re = bu_re.at[:, 0].add(ab_re * s0r - ab_im * s0i)
    bu_im = bu_im.at[:, 0].add(ab_re * s0i + ab_im * s0r)
    a_re = jnp.broadcast_to(ab_re, bu_re.shape)
    a_im = jnp.broadcast_to(ab_im, bu_im.shape)

    def combine(e1, e2):
        a1r, a1i, b1r, b1i = e1
        a2r, a2i, b2r, b2i = e2
        return (a1r * a2r - a1i * a2i,
                a1r * a2i + a1i * a2r,
                a2r * b1r - a2i * b1i + b2r,
                a2r * b1i + a2i * b1r + b2i)

    _, _, x_re, x_im = lax.associative_scan(combine, (a_re, a_im, bu_re, bu_im), axis=1)
    y = (jnp.einsum('blgp,ghp->blgh', x_re, c_re.astype(f32))
         - jnp.einsum('blgp,ghp->blgh', x_im, c_im.astype(f32)))
    y = y.reshape(bsz, L, SSM_WIDTH) + d_skip.astype(f32) * uf
    return y.astype(u.dtype), x_re[:, -1], x_im[:, -1]


def token_mixer(u, lp, attend, s0_re, s0_im):
    bsz, L, _ = u.shape
    q, k, v, xs, ga, gb = jnp.split(u @ lp['w_in'], IN_SPLITS, axis=-1)
    q = q.reshape(bsz, L, SB_HEADS, SB_HEAD_DIM)
    k = k.reshape(bsz, L, SB_HEADS, SB_HEAD_DIM)
    v = v.reshape(bsz, L, SB_HEADS, SB_HEAD_DIM)
    o_a = attend(q, k, v, lp['sb_bias']).reshape(bsz, L, SB_WIDTH)
    y, sr, si = s5_ssm(xs, lp['ssm_lambda_re'], lp['ssm_lambda_im'], lp['ssm_log_dt'],
                       lp['ssm_b_re'], lp['ssm_b_im'], lp['ssm_c_re'], lp['ssm_c_im'],
                       lp['ssm_d'], s0_re, s0_im)
    zg = jax.nn.gelu(y)
    o_b = zg * jax.nn.sigmoid(zg @ lp['glu_w'] + lp['glu_b'])
    merged = (jax.nn.sigmoid(ga) * (o_a @ lp['w_branch_a'])
              + jax.nn.sigmoid(gb) * (o_b @ lp['w_branch_b']))
    return merged @ lp['w_out'], k, v, sr, si


def decoder_layer(x, c, lp, attend, s0_re, s0_im):
    mod = jax.nn.silu(c) @ lp['ada_w'] + lp['ada_b']
    sh1, sc1, g1, sh2, sc2, g2, sh3, sc3, g3 = jnp.split(mod, ADA_CHUNKS, axis=-1)
    h = x + 0.5 * g1[:, None, :] * swiglu(rms_modulate(x, lp['norm_ffn1'], sh1, sc1),
                                          lp['ffn1_w_in'], lp['ffn1_w_out'])
    mix, k, v, sr, si = token_mixer(rms_modulate(h, lp['norm_mix'], sh2, sc2), lp, attend, s0_re, s0_im)
    h = h + g2[:, None, :] * mix
    h = h + 0.5 * g3[:, None, :] * swiglu(rms_modulate(h, lp['norm_ffn2'], sh3, sc3),
                                          lp['ffn2_w_in'], lp['ffn2_w_out'])
    return h, k, v, sr, si


def setup_inputs(seed: int = 0) -> dict:
    key = jax.random.key(seed)
    ks = iter(jax.random.split(key, 40))
    f32 = jnp.float32

    def nrm(shape, scale=1.0):
        return scale * jax.random.normal(next(ks), shape, f32)

    n_pages = PAST_LEN // PAGE_SIZE
    n_used = DEC_BATCH * n_pages
    n_pool = n_used + max(1, n_used // 4)
    cache_shape = (DEPTH, n_pool, PAGE_SIZE, SB_HEADS, SB_HEAD_DIM)
    state_shape = (DEPTH, DEC_BATCH, SSM_GROUPS, SSM_STATE)
    x_prompt = nrm((BATCH, SEQ, D_MODEL))
    x_sample = nrm((DEC_BATCH, DEC_SEQ, D_MODEL))
    c_prompt = nrm((BATCH, D_MODEL))
    c_sample = nrm((DEC_BATCH, D_MODEL))
    cache_k = nrm(cache_shape)
    cache_v = nrm(cache_shape)
    state_ssm_re = nrm(state_shape, 0.1)
    state_ssm_im = nrm(state_shape, 0.1)
    page_table = jax.random.permutation(next(ks), n_pool)[:n_used].reshape(DEC_BATCH, n_pages).astype(jnp.int32)
    gs = (DEPTH, SSM_GROUPS, SSM_STATE)
    lam_im_base = jnp.broadcast_to(jnp.pi * jnp.arange(SSM_STATE, dtype=f32), gs)
    return {
        'x_prompt': x_prompt, 'x_sample': x_sample,
        'c_prompt': c_prompt, 'c_sample': c_sample,
        'cache_k': cache_k, 'cache_v': cache_v,
        'state_ssm_re': state_ssm_re, 'state_ssm_im': state_ssm_im,
        'page_table': page_table,
        'ada_w': nrm((DEPTH, D_MODEL, ADA_CHUNKS * D_MODEL), D_MODEL ** -0.5),
        'ada_b': nrm((DEPTH, ADA_CHUNKS * D_MODEL), 0.01),
        'norm_ffn1': 1.0 + nrm((DEPTH, D_MODEL), 0.01),
        'ffn1_w_in': nrm((DEPTH, D_MODEL, 2 * D_FF), D_MODEL ** -0.5),
        'ffn1_w_out': nrm((DEPTH, D_FF, D_MODEL), D_FF ** -0.5),
        'norm_mix': 1.0 + nrm((DEPTH, D_MODEL), 0.01),
        'w_in': nrm((DEPTH, D_MODEL, IN_WIDTH), D_MODEL ** -0.5),
        'sb_bias': SB_BIAS_INIT + nrm((DEPTH, SB_HEADS), 0.1),
        'ssm_lambda_re': -0.5 + nrm(gs, 0.01),
        'ssm_lambda_im': lam_im_base + nrm(gs, 0.01),
        'ssm_log_dt': jax.random.uniform(next(ks), (DEPTH, SSM_GROUPS), f32, math.log(DT_MIN), math.log(DT_MAX)),
        'ssm_b_re': nrm((DEPTH, SSM_GROUPS, SSM_STATE, SSM_GROUP), (2 * SSM_GROUP) ** -0.5),
        'ssm_b_im': nrm((DEPTH, SSM_GROUPS, SSM_STATE, SSM_GROUP), (2 * SSM_GROUP) ** -0.5),
        'ssm_c_re': nrm((DEPTH, SSM_GROUPS, SSM_GROUP, SSM_STATE), SSM_STATE ** -0.5),
        'ssm_c_im': nrm((DEPTH, SSM_GROUPS, SSM_GROUP, SSM_STATE), SSM_STATE ** -0.5),
        'ssm_d': nrm((DEPTH, SSM_WIDTH)),
        'glu_w': nrm((DEPTH, SSM_WIDTH, SSM_WIDTH), SSM_WIDTH ** -0.5),
        'glu_b': nrm((DEPTH, SSM_WIDTH), 0.01),
        'w_branch_a': nrm((DEPTH, SB_WIDTH, D_MODEL), SB_WIDTH ** -0.5),
        'w_branch_b': nrm((DEPTH, SSM_WIDTH, D_MODEL), SSM_WIDTH ** -0.5),
        'w_out': nrm((DEPTH, D_MODEL, D_MODEL), D_MODEL ** -0.5),
        'norm_ffn2': 1.0 + nrm((DEPTH, D_MODEL), 0.01),
        'ffn2_w_in': nrm((DEPTH, D_MODEL, 2 * D_FF), D_MODEL ** -0.5),
        'ffn2_w_out': nrm((DEPTH, D_FF, D_MODEL), D_FF ** -0.5),
        'final_norm': 1.0 + nrm((D_MODEL,), 0.01),
    }


def reference(x_prompt, x_sample, c_prompt, c_sample, cache_k, cache_v, state_ssm_re, state_ssm_im,
              page_table, ada_w, ada_b, norm_ffn1, ffn1_w_in, ffn1_w_out, norm_mix, w_in, sb_bias,
              ssm_lambda_re, ssm_lambda_im, ssm_log_dt, ssm_b_re, ssm_b_im, ssm_c_re, ssm_c_im,
              ssm_d, glu_w, glu_b, w_branch_a, w_branch_b, w_out, norm_ffn2, ffn2_w_in,
              ffn2_w_out, final_norm):
    dec_b, n_pages = page_table.shape
    past_len = n_pages * PAGE_SIZE
    hp, hs = x_prompt, x_sample
    zero_state = jnp.zeros((x_prompt.shape[0], SSM_GROUPS, SSM_STATE), x_prompt.dtype)
    kp_l, vp_l, srp_l, sip_l, ks_l, vs_l, srs_l, sis_l = [], [], [], [], [], [], [], []
    for l in range(DEPTH):
        lp = dict(ada_w=ada_w[l], ada_b=ada_b[l], norm_ffn1=norm_ffn1[l], ffn1_w_in=ffn1_w_in[l],
                  ffn1_w_out=ffn1_w_out[l], norm_mix=norm_mix[l], w_in=w_in[l], sb_bias=sb_bias[l],
                  ssm_lambda_re=ssm_lambda_re[l], ssm_lambda_im=ssm_lambda_im[l],
                  ssm_log_dt=ssm_log_dt[l], ssm_b_re=ssm_b_re[l], ssm_b_im=ssm_b_im[l],
                  ssm_c_re=ssm_c_re[l], ssm_c_im=ssm_c_im[l], ssm_d=ssm_d[l], glu_w=glu_w[l],
                  glu_b=glu_b[l], w_branch_a=w_branch_a[l], w_branch_b=w_branch_b[l], w_out=w_out[l],
                  norm_ffn2=norm_ffn2[l], ffn2_w_in=ffn2_w_in[l], ffn2_w_out=ffn2_w_out[l])
        past_k = cache_k[l][page_table].reshape(dec_b, past_len, SB_HEADS, SB_HEAD_DIM)
        past_v = cache_v[l][page_table].reshape(dec_b, past_len, SB_HEADS, SB_HEAD_DIM)
        hp, kp, vp, srp, sip = decoder_layer(hp, c_prompt, lp, sb_prompt, zero_state, zero_state)
        hs, ks, vs, srs, sis = decoder_layer(hs, c_sample, lp,
                                             functools.partial(sb_sample, past_k=past_k, past_v=past_v),
                                             state_ssm_re[l], state_ssm_im[l])
        kp_l.append(kp); vp_l.append(vp); srp_l.append(srp); sip_l.append(sip)
        ks_l.append(ks); vs_l.append(vs); srs_l.append(srs); sis_l.append(sis)
    y_prompt = rmsnorm(hp, final_norm)
    y_sample = rmsnorm(hs, final_norm)
    return (y_prompt, y_sample,
            jnp.stack(kp_l), jnp.stack(vp_l), jnp.stack(srp_l), jnp.stack(sip_l),
            jnp.stack(ks_l), jnp.stack(vs_l), jnp.stack(srs_l), jnp.stack(sis_l))
```

```cpp
#include <hip/hip_runtime.h>
#include <cstdio>
#include <cstdint>

constexpr int D = 1024, NP = 16384, NS = 1024, M = NP + NS, FF = 2816, NIN = 4096, HW = 512, NSEQ = 132, NMOD = 9216;
constexpr int SEQ = 4096, PB = 4, SB = 128, ST = 8, NHEAD = 8, HD = 64, NGRP = 32, NSTATE = 64, PAST = 2048, PAGE = 128, NPAGES = 16;
constexpr int SSM_T = 64, SSM_NCH = SEQ / SSM_T;
constexpr float RMS_EPS = 1e-6f, LOG2E = 1.4426950408889634f, QSCALE = 0.125f * 1.4426950408889634f;
constexpr int MOD_SH1 = 0, MOD_SC1 = 1024, MOD_G1 = 2048, MOD_SH2 = 3072, MOD_SC2 = 4096, MOD_G2 = 5120, MOD_SH3 = 6144, MOD_SC3 = 7168, MOD_G3 = 8192;
constexpr size_t O_YP = 0, O_YS = 16777216, O_KP = 17825792, O_VP = 26214400, O_SRP = 34603008, O_SIP = 34611200, O_KS = 34619392, O_VS = 35143680, O_SRS = 35667968, O_SIS = 35930112, O_TOTAL = 36192256;
__host__ __device__ __forceinline__ int seq_of_row(int row) { return row < NP ? (row >> 12) : 4 + ((row - NP) >> 3); }
namespace pg8 {
#define PG8_LAS __attribute__((address_space(3)))
typedef unsigned short bf16_t;
typedef short bf16x8 __attribute__((ext_vector_type(8)));
typedef float f32x4 __attribute__((ext_vector_type(4)));
typedef unsigned u32x4 __attribute__((ext_vector_type(4)));
constexpr int BM = 256, BK = 64, HALF = 128, HTB = HALF * BK * 2  , STAGE_BYTES = 8 * HTB, NXCD = 8, WGM = 8;

__host__ __device__ __forceinline__ int lds_byte(int r, int c) { const int st = (r >> 4) * 2 + (c >> 5), rr = r & 15, cc = c & 31, ob = rr * 64 + cc * 2; return st * 1024 + (ob ^ (((ob >> 9) & 1) << 5)); }
__host__ __device__ __forceinline__ void stage_rc(int b, int& R, int& C) { const int st = b / 1024, sb = b % 1024, swz = sb ^ (((sb >> 9) & 1) << 5); R = (st >> 1) * 16 + swz / 64; C = (st & 1) * 32 + (swz % 64) / 2; }
__host__ __device__ __forceinline__ int perm32(int rho) { const int n = rho >> 4, i = rho & 15; return 8 * (i >> 2) + 4 * n + (i & 3); }

struct Unit { int pm, pn, sel; };
struct Gemm { const bf16_t* A; const bf16_t* Bt; int M, N, K; const bf16_t* A2; const bf16_t* Bt2; };

struct StaticOrder {
    int nM, nN, nwg, G, c;
    __host__ __device__ void init(int M, int N, int G_, int c_) { nM = M / BM; nN = N / BM; nwg = nM * nN; G = G_; c = c_; }
    __host__ __device__ bool next(int i, Unit& u) const {
        const long L = (long)i * G + c; if (L >= nwg) return false;
        int wgid = (int)L; { const int q = nwg / NXCD, r = nwg % NXCD, xcd = wgid % NXCD, off = wgid / NXCD; wgid = (xcd < r ? xcd * (q + 1) : r * (q + 1) + (xcd - r) * q) + off; }
        const int nig = WGM * nN, gid = wgid / nig, fm = gid * WGM, gsz = (nM - fm) < WGM ? (nM - fm) : WGM;
        u.pm = fm + ((wgid % nig) % gsz); u.pn = (wgid % nig) / gsz; u.sel = 0; return true;
    }
    __device__ __forceinline__ void a_ready(const Unit&) const {}
    __device__ __forceinline__ void done(const Unit&) const {}
};

typedef float f32x2c __attribute__((ext_vector_type(2))); typedef __bf16 bf16x2c __attribute__((ext_vector_type(2)));
__device__ __forceinline__ unsigned cvt_pk_bf16(float lo, float hi) { f32x2c v = {lo, hi}; bf16x2c b = __builtin_convertvector(v, bf16x2c); return __builtin_bit_cast(unsigned, b); }
typedef float f32x2 __attribute__((ext_vector_type(2)));
__device__ __forceinline__ float sigm(float x) { return __builtin_amdgcn_rcpf(1.0f + __builtin_amdgcn_exp2f(-x * LOG2E)); }
__device__ __forceinline__ float bf_lo(unsigned w) { return __builtin_bit_cast(float, w << 16); }
__device__ __forceinline__ float bf_hi(unsigned w) { return __builtin_bit_cast(float, w & 0xffff0000u); }

struct EpiMod {
    static constexpr bool PERM = false, AFTER_DRAIN = false;
    float* mod; const float* bias;
    __device__ __forceinline__ void operator()(const f32x4 (&acc)[2][2][4][2], const Unit& u, int wr, int wc, int fr, int fq) const {
        const int col0 = u.pn * BM + wc * 32 + 4 * fq;
#pragma unroll
        for (int ai = 0; ai < 2; ++ai)
#pragma unroll
            for (int m = 0; m < 4; ++m) { const int row = u.pm * BM + ai * HALF + wr * 64 + m * 16 + fr;
                if (row < NSEQ) {
#pragma unroll
                    for (int bj = 0; bj < 2; ++bj)
#pragma unroll
                        for (int n = 0; n < 2; ++n) { const int col = col0 + bj * HALF + n * 16;
                            *(f32x4*)(mod + (size_t)row * NMOD + col) = acc[ai][bj][m][n] + *(const f32x4*)(bias + col); } } }
    }
};

struct EpiSwiglu {
    static constexpr bool PERM = true, AFTER_DRAIN = false;
    bf16_t* H;
    __device__ __forceinline__ void operator()(const f32x4 (&acc)[2][2][4][2], const Unit& u, int wr, int wc, int fr, int fq) const {
        const int row0 = u.pm * BM + wr * 64 + fr, col0 = u.pn * HALF + wc * 32 + 8 * fq;
#pragma unroll
        for (int ai = 0; ai < 2; ++ai)
#pragma unroll
            for (int m = 0; m < 4; ++m) { bf16_t* rowp = H + (size_t)(row0 + ai * HALF + m * 16) * FF + col0;
                float o[8];
#pragma unroll
                for (int n = 0; n < 2; ++n)
#pragma unroll
                    for (int e = 0; e < 4; ++e) { const float g = acc[ai][0][m][n][e], up = acc[ai][1][m][n][e]; o[n * 4 + e] = g * sigm(g) * up; }
                u32x4 w; w.x = cvt_pk_bf16(o[0], o[1]); w.y = cvt_pk_bf16(o[2], o[3]); w.z = cvt_pk_bf16(o[4], o[5]); w.w = cvt_pk_bf16(o[6], o[7]);
                *(u32x4*)rowp = w; }
    }
};

struct EpiResid {
    static constexpr bool PERM = false, AFTER_DRAIN = false;
    const float* base_p; const float* base_s; float* out; const float* mod; int goff; float scale;
    __device__ __forceinline__ void operator()(const f32x4 (&acc)[2][2][4][2], const Unit& u, int wr, int wc, int fr, int fq) const {
        const int col0 = u.pn * BM + wc * 32 + 4 * fq;
#pragma unroll
        for (int ai = 0; ai < 2; ++ai)
#pragma unroll
            for (int m = 0; m < 4; ++m) { const int row = u.pm * BM + ai * HALF + wr * 64 + m * 16 + fr;
                const float* bp = (row < NP ? base_p + (size_t)row * D : base_s + (size_t)(row - NP) * D) + col0;
                const float* gp = mod + (size_t)seq_of_row(row) * NMOD + goff + col0; float* op = out + (size_t)row * D + col0;
#pragma unroll
                for (int bj = 0; bj < 2; ++bj)
#pragma unroll
                    for (int n = 0; n < 2; ++n) { const int c = bj * HALF + n * 16;
                        const f32x4 b = *(const f32x4*)(bp + c), g = *(const f32x4*)(gp + c);
                        *(f32x4*)(op + c) = b + (g * scale) * acc[ai][bj][m][n]; } }
    }
};

struct EpiInproj {
    static constexpr bool PERM = true, AFTER_DRAIN = false;
    bf16_t* Q; bf16_t* KB; bf16_t* VB; float* S; bf16_t* GA; bf16_t* GB; float* dout;
    __device__ __forceinline__ void operator()(const f32x4 (&acc)[2][2][4][2], const Unit& u, int wr, int wc, int fr, int fq) const {
        const int row0 = u.pm * BM + wr * 64 + fr, ct = wc * 32 + 8 * fq, pn = u.pn;
#pragma unroll
        for (int ai = 0; ai < 2; ++ai)
#pragma unroll
            for (int m = 0; m < 4; ++m) { const int row = row0 + ai * HALF + m * 16;
#pragma unroll
                for (int bj = 0; bj < 2; ++bj) { const f32x4 v0 = acc[ai][bj][m][0], v1 = acc[ai][bj][m][1];
                    if (pn < 2) { const int col = pn * BM + bj * HALF + ct; const f32x4 a = v0 * QSCALE, b = v1 * QSCALE;
                        u32x4 w; w.x = cvt_pk_bf16(a[0], a[1]); w.y = cvt_pk_bf16(a[2], a[3]); w.z = cvt_pk_bf16(b[0], b[1]); w.w = cvt_pk_bf16(b[2], b[3]);
                        *(u32x4*)(Q + (size_t)row * HW + col) = w;
                    } else if (pn < 6) { const bool isk = pn < 4; const int col = (pn - (isk ? 2 : 4)) * BM + bj * HALF + ct;
                        float* fo = dout + (row < NP ? (isk ? O_KP : O_VP) + (size_t)row * HW : (isk ? O_KS : O_VS) + (size_t)(row - NP) * HW) + col;
                        *(f32x4*)fo = v0; *(f32x4*)(fo + 4) = v1;
                        u32x4 w; w.x = cvt_pk_bf16(v0[0], v0[1]); w.y = cvt_pk_bf16(v0[2], v0[3]); w.z = cvt_pk_bf16(v1[0], v1[1]); w.w = cvt_pk_bf16(v1[2], v1[3]);
                        *(u32x4*)((isk ? KB : VB) + (size_t)row * HW + col) = w;
                    } else if (pn < 8) { const int col = (pn - 6) * BM + bj * HALF + ct; float* fo = S + (size_t)row * HW + col;
                        *(f32x4*)fo = v0; *(f32x4*)(fo + 4) = v1;
                    } else { const bool isa = pn < 12; const int col = (pn - (isa ? 8 : 12)) * BM + bj * HALF + ct;
                        u32x4 w; w.x = cvt_pk_bf16(sigm(v0[0]), sigm(v0[1])); w.y = cvt_pk_bf16(sigm(v0[2]), sigm(v0[3])); w.z = cvt_pk_bf16(sigm(v1[0]), sigm(v1[1])); w.w = cvt_pk_bf16(sigm(v1[2]), sigm(v1[3]));
                        *(u32x4*)((isa ? GA : GB) + (size_t)row * D + col) = w; } } }
    }
};

struct EpiGlu {
    static constexpr bool PERM = true, AFTER_DRAIN = false;
    const bf16_t* ZG; bf16_t* OB; const float* bias;
    __device__ __forceinline__ void operator()(const f32x4 (&acc)[2][2][4][2], const Unit& u, int wr, int wc, int fr, int fq) const {
        const int row0 = u.pm * BM + wr * 64 + fr, col0 = u.pn * BM + wc * 32 + 8 * fq;
#pragma unroll
        for (int ai = 0; ai < 2; ++ai)
#pragma unroll
            for (int m = 0; m < 4; ++m) { const int row = row0 + ai * HALF + m * 16;
#pragma unroll
                for (int bj = 0; bj < 2; ++bj) { const int col = col0 + bj * HALF;
                    const f32x4 v0 = acc[ai][bj][m][0] + *(const f32x4*)(bias + col), v1 = acc[ai][bj][m][1] + *(const f32x4*)(bias + col + 4);
                    const u32x4 z = *(const u32x4*)(ZG + (size_t)row * HW + col);
                    u32x4 w; w.x = cvt_pk_bf16(bf_lo(z.x) * sigm(v0[0]), bf_hi(z.x) * sigm(v0[1])); w.y = cvt_pk_bf16(bf_lo(z.y) * sigm(v0[2]), bf_hi(z.y) * sigm(v0[3]));
                    w.z = cvt_pk_bf16(bf_lo(z.z) * sigm(v1[0]), bf_hi(z.z) * sigm(v1[1])); w.w = cvt_pk_bf16(bf_lo(z.w) * sigm(v1[2]), bf_hi(z.w) * sigm(v1[3]));
                    *(u32x4*)(OB + (size_t)row * HW + col) = w; } }
    }
};

struct EpiBranch {
    static constexpr bool PERM = true, AFTER_DRAIN = false;
    const bf16_t* GA; const bf16_t* GB; float* TMP; bf16_t* MRG;
    __device__ __forceinline__ void operator()(const f32x4 (&acc)[2][2][4][2], const Unit& u, int wr, int wc, int fr, int fq) const {
        const int row0 = u.pm * BM + wr * 64 + fr, col0 = u.pn * BM + wc * 32 + 8 * fq; const bool second = u.sel != 0;
#pragma unroll
        for (int ai = 0; ai < 2; ++ai)
#pragma unroll
            for (int m = 0; m < 4; ++m) { const int row = row0 + ai * HALF + m * 16;
#pragma unroll
                for (int bj = 0; bj < 2; ++bj) { const int col = col0 + bj * HALF; const size_t off = (size_t)row * D + col;
                    const u32x4 gz = *(const u32x4*)((second ? GB : GA) + off);
                    f32x4 g0 = (f32x4){bf_lo(gz.x), bf_hi(gz.x), bf_lo(gz.y), bf_hi(gz.y)}, g1 = (f32x4){bf_lo(gz.z), bf_hi(gz.z), bf_lo(gz.w), bf_hi(gz.w)};
                    f32x4 t0 = g0 * acc[ai][bj][m][0], t1 = g1 * acc[ai][bj][m][1];
                    if (!second) { *(f32x4*)(TMP + off) = t0; *(f32x4*)(TMP + off + 4) = t1; }
                    else { t0 += *(const f32x4*)(TMP + off); t1 += *(const f32x4*)(TMP + off + 4);
                        u32x4 w; w.x = cvt_pk_bf16(t0[0], t0[1]); w.y = cvt_pk_bf16(t0[2], t0[3]); w.z = cvt_pk_bf16(t1[0], t1[1]); w.w = cvt_pk_bf16(t1[2], t1[3]);
                        *(u32x4*)(MRG + off) = w; } } }
    }
};

struct SelOrder {
    StaticOrder so; int sel;
    __device__ void init(int M_, int N_, int G_, int c_, int sel_) { so.init(M_, N_, G_, c_); sel = sel_; }
    __device__ bool next(int i, Unit& u) const { if (!so.next(i, u)) return false; u.sel = sel; return true; }
    __device__ __forceinline__ void a_ready(const Unit&) const {}
    __device__ __forceinline__ void done(const Unit&) const {}
};
struct PairOrder {
    StaticOrder so;
    __device__ void init(int M_, int N_, int G_, int c_) { so.init(M_, N_, G_, c_); }
    __device__ bool next(int i, Unit& u) const { if (!so.next(i >> 1, u)) return false; u.sel = i & 1; return true; }
    __device__ __forceinline__ void a_ready(const Unit&) const {}
    __device__ __forceinline__ void done(const Unit&) const {}
};
template <class Epi, class Sched, bool ALIGN_EPI = false, bool SP2 = false>
__device__ __forceinline__ void gemm_phase(PG8_LAS unsigned char* lds, const Gemm g, const Sched& S, const Epi& E) {
    const int tid = threadIdx.x, wid = __builtin_amdgcn_readfirstlane(tid >> 6), lane = tid & 63, wr = wid >> 2, wc = wid & 3, fr = lane & 15, fq = lane >> 4;
    const int K = g.K, nt = K / BK;
    unsigned voffA[2], voffB[2];
#pragma unroll
    for (int i = 0; i < 2; ++i) { int R, C; stage_rc(tid * 16 + i * 8192, R, C); const int Rb = Epi::PERM ? ((R & ~31) + perm32(R & 31)) : R;
        voffA[i] = (unsigned)(R * K + C) * 2u; voffB[i] = (unsigned)(Rb * K + C) * 2u; }
    const size_t kstep = (size_t)(BK * 2);
    const size_t hstep = (size_t)HALF * K * 2;
    const size_t tstep = 2 * hstep;
    const unsigned ldsw = (unsigned)wid * 1024u;
    const int aoff = lds_byte(wr * 64 + fr, fq * 8), boff = lds_byte(wc * 32 + fr, fq * 8);
#define PG8_SA(b, h) (((b) * 2 + (h)) * HTB)
#define PG8_SB(b, h) ((4 + (b) * 2 + (h)) * HTB)
#define PG8_STAGE(bufoff, gbase, voff) do { _Pragma("unroll") for (int _i = 0; _i < 2; ++_i) \
        __builtin_amdgcn_global_load_lds((const unsigned*)((const char*)(gbase) + (voff)[_i]), (PG8_LAS unsigned*)(lds + (bufoff) + ldsw + _i * 8192), 16, 0, 0); } while (0)
#define PG8_LDA(dst, b, h) do { _Pragma("unroll") for (int m = 0; m < 4; ++m) _Pragma("unroll") for (int k = 0; k < 2; ++k) dst[m][k] = *(const PG8_LAS bf16x8*)(lds + PG8_SA(b, h) + aoff + m * 2048 + k * 1024); } while (0)
#define PG8_LDB(dst, b, h) do { _Pragma("unroll") for (int n = 0; n < 2; ++n) _Pragma("unroll") for (int k = 0; k < 2; ++k) dst[n][k] = *(const PG8_LAS bf16x8*)(lds + PG8_SB(b, h) + boff + n * 2048 + k * 1024); } while (0)
#define PG8_MMA(ai, bj, At, Bt) do { __builtin_amdgcn_s_setprio(1); _Pragma("unroll") for (int m = 0; m < 4; ++m) _Pragma("unroll") for (int n = 0; n < 2; ++n) _Pragma("unroll") for (int k = 0; k < 2; ++k) \
        acc[ai][bj][m][n] = __builtin_amdgcn_mfma_f32_16x16x32_bf16(Bt[n][k], At[m][k], acc[ai][bj][m][n], 0, 0, 0); __builtin_amdgcn_s_setprio(0); } while (0)
#define PG8_WAIT_V(n) asm volatile("s_waitcnt vmcnt(" #n ")" ::: "memory")
#define PG8_WAIT_L(n) asm volatile("s_waitcnt lgkmcnt(" #n ")" ::: "memory")
#define PG8_BAR __builtin_amdgcn_s_barrier()
#define PG8_SCHED __builtin_amdgcn_sched_barrier(0)
    Unit cur, nxt; int ui = 0;
    if (!S.next(0, cur)) return;
    f32x4 acc[2][2][4][2];
#pragma unroll
    for (int a = 0; a < 2; ++a)
#pragma unroll
        for (int b = 0; b < 2; ++b)
#pragma unroll
            for (int m = 0; m < 4; ++m)
#pragma unroll
                for (int n = 0; n < 2; ++n) acc[a][b][m][n] = (f32x4){0.f, 0.f, 0.f, 0.f};
    bf16x8 At[4][2], B0[2][2], B1[2][2];
    const char* cA = (const char*)(cur.sel ? g.A2 : g.A) + (size_t)cur.pm * tstep; const char* cB = (const char*)(cur.sel ? g.Bt2 : g.Bt) + (size_t)cur.pn * tstep;
    S.a_ready(cur);
    if constexpr (SP2) {
        PG8_STAGE(PG8_SB(0, 0), cB, voffB); PG8_STAGE(PG8_SB(0, 1), cB + hstep, voffB); PG8_STAGE(PG8_SA(0, 0), cA, voffA); PG8_STAGE(PG8_SA(0, 1), cA + hstep, voffA);
        if (wr == 1) PG8_BAR;
        PG8_WAIT_V(2); PG8_BAR;
        PG8_STAGE(PG8_SB(1, 0), cB + kstep, voffB); PG8_STAGE(PG8_SA(1, 0), cA + kstep, voffA); PG8_STAGE(PG8_SB(1, 1), cB + hstep + kstep, voffB);
        PG8_WAIT_V(6); PG8_BAR;
    } else {
        PG8_STAGE(PG8_SB(0, 0), cB, voffB); PG8_STAGE(PG8_SA(0, 0), cA, voffA); PG8_STAGE(PG8_SB(0, 1), cB + hstep, voffB); PG8_STAGE(PG8_SA(0, 1), cA + hstep, voffA);
        if (wr == 1) PG8_BAR;
        PG8_WAIT_V(4); PG8_BAR;
        PG8_STAGE(PG8_SB(1, 0), cB + kstep, voffB); PG8_STAGE(PG8_SA(1, 0), cA + kstep, voffA); PG8_STAGE(PG8_SB(1, 1), cB + hstep + kstep, voffB);
        PG8_WAIT_V(6); PG8_BAR;
    }
    for (;;) {
        const bool has_next = S.next(ui + 1, nxt);
        const char* nA = has_next ? (const char*)(nxt.sel ? g.A2 : g.A) + (size_t)nxt.pm * tstep : cA; const char* nB = has_next ? (const char*)(nxt.sel ? g.Bt2 : g.Bt) + (size_t)nxt.pn * tstep : cB;
        for (int t = 0; t < nt; t += 2) {
            const bool last = (t == nt - 2);
            const char* a1 = cA + (size_t)(t + 1) * kstep;
            const char* a2 = last ? nA : cA + (size_t)(t + 2) * kstep; const char* b2 = last ? nB : cB + (size_t)(t + 2) * kstep;
            const char* a3 = a2 + kstep; const char* b3 = b2 + kstep;
            if (last && has_next) S.a_ready(nxt);
            if constexpr (SP2) {
            PG8_LDB(B0, 0, 0); PG8_LDB(B1, 0, 1); PG8_SCHED; PG8_LDA(At, 0, 0); PG8_STAGE(PG8_SA(1, 1), a1 + hstep, voffA);
            PG8_WAIT_V(8); PG8_WAIT_L(0); PG8_BAR; PG8_MMA(0, 0, At, B0); PG8_MMA(0, 1, At, B1); PG8_BAR; PG8_SCHED;
            PG8_LDA(At, 0, 1); PG8_STAGE(PG8_SB(0, 0), b2, voffB); PG8_STAGE(PG8_SB(0, 1), b2 + hstep, voffB); PG8_STAGE(PG8_SA(0, 0), a2, voffA);
            PG8_WAIT_V(8); PG8_WAIT_L(0); PG8_BAR; PG8_MMA(1, 0, At, B0); PG8_MMA(1, 1, At, B1); PG8_BAR; PG8_SCHED;
            PG8_LDB(B0, 1, 0); PG8_LDB(B1, 1, 1); PG8_SCHED; PG8_LDA(At, 1, 0); PG8_STAGE(PG8_SA(0, 1), a2 + hstep, voffA);
            PG8_WAIT_V(8); PG8_WAIT_L(0); PG8_BAR; PG8_MMA(0, 0, At, B0); PG8_MMA(0, 1, At, B1); PG8_BAR; PG8_SCHED;
            PG8_LDA(At, 1, 1); PG8_STAGE(PG8_SB(1, 0), b3, voffB); PG8_STAGE(PG8_SB(1, 1), b3 + hstep, voffB); PG8_STAGE(PG8_SA(1, 0), a3, voffA);
            PG8_WAIT_V(8); PG8_WAIT_L(0); PG8_BAR; PG8_MMA(1, 0, At, B0); PG8_MMA(1, 1, At, B1); PG8_BAR; PG8_SCHED;
            } else {
            PG8_LDB(B0, 0, 0); PG8_SCHED; PG8_LDA(At, 0, 0); PG8_STAGE(PG8_SA(1, 1), a1 + hstep, voffA);
            PG8_WAIT_L(8); PG8_BAR; PG8_WAIT_L(0); PG8_MMA(0, 0, At, B0); PG8_BAR; PG8_SCHED;
            PG8_LDB(B1, 0, 1); PG8_STAGE(PG8_SB(0, 0), b2, voffB);
            PG8_BAR; PG8_WAIT_L(0); PG8_MMA(0, 1, At, B1); PG8_BAR;
            PG8_LDA(At, 0, 1); PG8_STAGE(PG8_SA(0, 0), a2, voffA);
            PG8_BAR; PG8_WAIT_L(0); PG8_MMA(1, 0, At, B0); PG8_BAR; PG8_SCHED;
            PG8_STAGE(PG8_SB(0, 1), b2 + hstep, voffB);
            PG8_WAIT_V(6); PG8_BAR; PG8_MMA(1, 1, At, B1); PG8_BAR;
            PG8_LDB(B0, 1, 0); PG8_SCHED; PG8_LDA(At, 1, 0); PG8_STAGE(PG8_SA(0, 1), a2 + hstep, voffA);
            PG8_WAIT_L(8); PG8_BAR; PG8_WAIT_L(0); PG8_MMA(0, 0, At, B0); PG8_BAR; PG8_SCHED;
            PG8_LDB(B1, 1, 1); PG8_STAGE(PG8_SB(1, 0), b3, voffB);
            PG8_BAR; PG8_WAIT_L(0); PG8_MMA(0, 1, At, B1); PG8_BAR;
            PG8_LDA(At, 1, 1); PG8_STAGE(PG8_SA(1, 0), a3, voffA);
            PG8_BAR; PG8_WAIT_L(0); PG8_MMA(1, 0, At, B0); PG8_BAR; PG8_SCHED;
            PG8_STAGE(PG8_SB(1, 1), b3 + hstep, voffB);
            PG8_WAIT_V(6); PG8_BAR; PG8_MMA(1, 1, At, B1); PG8_BAR;
            }
        }
        if constexpr (ALIGN_EPI) { if (wr == 0) PG8_BAR; }
        if constexpr (!Epi::AFTER_DRAIN) { E(acc, cur, wr, wc, fr, fq); S.done(cur); }
        if (!has_next) break;
#pragma unroll
        for (int a = 0; a < 2; ++a)
#pragma unroll
            for (int b = 0; b < 2; ++b)
#pragma unroll
                for (int m = 0; m < 4; ++m)
#pragma unroll
                    for (int n = 0; n < 2; ++n) acc[a][b][m][n] = (f32x4){0.f, 0.f, 0.f, 0.f};
        cur = nxt; cA = nA; cB = nB; ++ui;
        if constexpr (ALIGN_EPI) { if (wr == 1) PG8_BAR; }
    }
    PG8_WAIT_V(0);
    if constexpr (!ALIGN_EPI) { if (wr == 0) PG8_BAR; }
    PG8_BAR;
    if constexpr (Epi::AFTER_DRAIN) { E.fused(acc, cur, wr, wc, fr, fq, lds, wid, lane); S.done(cur); }
#undef PG8_SA
#undef PG8_SB
#undef PG8_STAGE
#undef PG8_LDA
#undef PG8_LDB
#undef PG8_MMA
#undef PG8_WAIT_V
#undef PG8_WAIT_L
#undef PG8_BAR
#undef PG8_SCHED
}
}

namespace sba {
typedef short bf16x8 __attribute__((ext_vector_type(8)));
typedef short s16x4 __attribute__((ext_vector_type(4)));
typedef float f32x16 __attribute__((ext_vector_type(16)));
typedef unsigned u32x4 __attribute__((ext_vector_type(4)));
typedef unsigned short bf16_t;
typedef __attribute__((address_space(3))) const char* lds_cptr;
typedef __attribute__((address_space(3))) char* lds_ptr;
constexpr int DM = 512, SLOTB = 8192, LK = 0, LV = 2 * SLOTB, LOST = 4 * SLOTB, LBYTES = LOST + 8 * 4096;
__device__ __forceinline__ void glds16(const void* gsrc, unsigned lds_dst) { unsigned keep;
    asm volatile("s_mov_b32 %0, m0\n\ts_mov_b32 m0, %2\n\ts_nop 0\n\tglobal_load_lds_dwordx4 %1, off\n\ts_mov_b32 m0, %0" : "=&s"(keep) : "v"(gsrc), "s"(lds_dst) : "memory"); }
typedef float f32x2_t __attribute__((ext_vector_type(2))); typedef __bf16 bf16x2_t __attribute__((ext_vector_type(2)));
__device__ __forceinline__ unsigned cvtpk(float lo, float hi) { f32x2_t v = {lo, hi}; bf16x2_t b = __builtin_convertvector(v, bf16x2_t); return __builtin_bit_cast(unsigned, b); }
#define SBA_WAIT_BAR() asm volatile("s_waitcnt vmcnt(0) lgkmcnt(0)\n\ts_barrier" ::: "memory")

__device__ __forceinline__ void qkt(f32x16& p0, f32x16& p1, lds_cptr kp, const bf16x8* qr, const f32x16& cin) {
#pragma unroll
    for (int d0 = 0; d0 < 4; ++d0) {
        const bf16x8 b0 = *(const __attribute__((address_space(3))) bf16x8*)(kp + d0 * 2048);
        const bf16x8 b1 = *(const __attribute__((address_space(3))) bf16x8*)(kp + d0 * 2048 + 512);
        if (d0 == 0) { p0 = __builtin_amdgcn_mfma_f32_32x32x16_bf16(b0, qr[0], cin, 0, 0, 0); p1 = __builtin_amdgcn_mfma_f32_32x32x16_bf16(b1, qr[0], cin, 0, 0, 0); }
        else { p0 = __builtin_amdgcn_mfma_f32_32x32x16_bf16(b0, qr[d0], p0, 0, 0, 0); p1 = __builtin_amdgcn_mfma_f32_32x32x16_bf16(b1, qr[d0], p1, 0, 0, 0); } }
}
__device__ __forceinline__ void pv(f32x16* o, int vb, bf16x8 pa0, bf16x8 pa1, bf16x8 pa2, bf16x8 pa3) {
#pragma unroll
    for (int d0 = 0; d0 < 2; ++d0) { s16x4 lo[4], hi[4];
#pragma unroll
        for (int ks = 0; ks < 4; ++ks) {
            asm volatile("ds_read_b64_tr_b16 %0,%1 offset:%c2" : "=&v"(lo[ks]) : "v"(vb), "i"(d0 * 4096 + ks * 1024) : "memory");
            asm volatile("ds_read_b64_tr_b16 %0,%1 offset:%c2" : "=&v"(hi[ks]) : "v"(vb), "i"(d0 * 4096 + ks * 1024 + 512) : "memory"); }
        asm volatile("s_waitcnt lgkmcnt(0)" ::: "memory"); __builtin_amdgcn_sched_barrier(0);
#define SBA_PK(k) (bf16x8){lo[k][0], lo[k][1], lo[k][2], lo[k][3], hi[k][0], hi[k][1], hi[k][2], hi[k][3]}
        o[d0] = __builtin_amdgcn_mfma_f32_32x32x16_bf16(pa0, SBA_PK(0), o[d0], 0, 0, 0);
        o[d0] = __builtin_amdgcn_mfma_f32_32x32x16_bf16(pa1, SBA_PK(1), o[d0], 0, 0, 0);
        o[d0] = __builtin_amdgcn_mfma_f32_32x32x16_bf16(pa2, SBA_PK(2), o[d0], 0, 0, 0);
        o[d0] = __builtin_amdgcn_mfma_f32_32x32x16_bf16(pa3, SBA_PK(3), o[d0], 0, 0, 0);
#undef SBA_PK
    }
}
__device__ __forceinline__ void unit(int b, int h, int qb, const bf16_t* Q, const bf16_t* __restrict__ K, const bf16_t* __restrict__ V, bf16_t* O, float bias2, lds_ptr shm) {
    const int tid = threadIdx.x, lane = tid & 63, r32 = lane & 31, hi = lane >> 5; const int wid = __builtin_amdgcn_readfirstlane(tid >> 6);
    const long rowbase = (long)b * SEQ; const int q0 = qb * 256;
    const bf16_t* Qw = Q + (rowbase + q0 + wid * 32) * DM + h * HD;
    const bf16_t* Kh = K + rowbase * DM + h * HD, * Vh = V + rowbase * DM + h * HD;
    const unsigned lds0 = (unsigned)(uintptr_t)shm;
    const bf16_t* ksrc = Kh + (long)lane * DM + wid * 8;
    const bf16_t* vsrc = Vh + (long)(16 * (wid & 3) + (lane >> 2)) * DM + (wid >> 2) * 32 + (lane & 3) * 8;
    const unsigned kdst = lds0 + LK + wid * 1024, vdst = lds0 + LV + wid * 1024;
#define SBA_DMA_K(t, slot) glds16(ksrc + (long)(t) * 64 * DM, (unsigned)__builtin_amdgcn_readfirstlane(kdst + (slot)))
#define SBA_DMA_V(t, slot) glds16(vsrc + (long)(t) * 64 * DM, (unsigned)__builtin_amdgcn_readfirstlane(vdst + (slot)))
    const int vb0 = (int)(lds0 + LV) + ((lane >> 4) & 1) * 32 + (lane & 3) * 8 + (4 * hi + ((lane & 15) >> 2)) * 64;
    const lds_cptr kp0 = (lds_cptr)shm + LK + hi * 1024 + r32 * 16;
    const int NT = (q0 + 256) / 64;
    SBA_DMA_K(NT - 1, ((NT - 1) & 1) * SLOTB); SBA_DMA_V(NT - 1, ((NT - 1) & 1) * SLOTB);
    bf16x8 qr[4];
#pragma unroll
    for (int d0 = 0; d0 < 4; ++d0) qr[d0] = *reinterpret_cast<const bf16x8*>(&Qw[(long)r32 * DM + d0 * 16 + hi * 8]);
    f32x16 o[2]; o[0] = f32x16{}; o[1] = f32x16{};
    f32x16 cin;
#pragma unroll
    for (int r = 0; r < 16; ++r) cin[r] = bias2;
    float C = 1.0f;
    const int qrel = wid * 32 + r32;
    for (int t = NT - 1; t >= 0; --t) {
        const int slot = (t & 1) * SLOTB;
        SBA_WAIT_BAR();
        if (t > 0) { SBA_DMA_K(t - 1, slot ^ SLOTB); SBA_DMA_V(t - 1, slot ^ SLOTB); }
        const int jb = t - (NT - 4);
        if (jb >= 0 && 64 * jb >= 32 * wid + 32) continue;
        f32x16 p0, p1;
        qkt(p0, p1, kp0 + slot, qr, cin);
#pragma unroll
        for (int r = 0; r < 16; ++r) { p0[r] = __builtin_fminf(p0[r], 60.0f); p1[r] = __builtin_fminf(p1[r], 60.0f); }
        if (jb >= 0) { const int kb = 64 * jb + 4 * hi;
#pragma unroll
            for (int r = 0; r < 16; ++r) { const int kv = kb + (r & 3) + 8 * (r >> 2); if (kv >= qrel) p0[r] = -__builtin_inff(); if (kv + 32 >= qrel) p1[r] = -__builtin_inff(); } }
        f32x16 e0, e1;
#pragma unroll
        for (int r = 0; r < 16; ++r) { e0[r] = __builtin_amdgcn_exp2f(p0[r]); e1[r] = __builtin_amdgcn_exp2f(p1[r]); }
#pragma unroll
        for (int r = 0; r < 16; ++r) { p0[r] = __builtin_amdgcn_rcpf(1.0f + e0[r]); p1[r] = __builtin_amdgcn_rcpf(1.0f + e1[r]); }
        float cgprev = 1.0f;
#pragma unroll
        for (int L = 0; L < 8; ++L) {
            f32x16& R = (L < 4) ? p1 : p0; f32x16& E = (L < 4) ? e1 : e0; const int g4 = 4 * (3 - (L & 3));
            R[g4 + 2] *= R[g4 + 3]; R[g4 + 1] *= R[g4 + 2]; R[g4 + 0] *= R[g4 + 1];
            const float cg = cgprev * R[g4 + 0];
            auto rr = __builtin_amdgcn_permlane32_swap(__float_as_uint(cg), __float_as_uint(cgprev), false, false);
            const float mL = hi ? __uint_as_float(rr[0]) : __uint_as_float(rr[1]);
            const float pre = (C * cgprev) * mL;
            E[g4 + 3] *= R[g4 + 3] * pre; E[g4 + 2] *= R[g4 + 2] * pre; E[g4 + 1] *= R[g4 + 1] * pre; E[g4 + 0] *= R[g4 + 0] * pre;
            cgprev = cg;
        }
        { auto rr = __builtin_amdgcn_permlane32_swap(__float_as_uint(cgprev), __float_as_uint(cgprev), false, false); C = C * (__uint_as_float(rr[0]) * __uint_as_float(rr[1])); }
        u32x4 pw0, pw1, pw2, pw3;
        pw0 = (u32x4){cvtpk(e0[0], e0[1]), cvtpk(e0[2], e0[3]), cvtpk(e0[4], e0[5]), cvtpk(e0[6], e0[7])};
        pw1 = (u32x4){cvtpk(e0[8], e0[9]), cvtpk(e0[10], e0[11]), cvtpk(e0[12], e0[13]), cvtpk(e0[14], e0[15])};
        pw2 = (u32x4){cvtpk(e1[0], e1[1]), cvtpk(e1[2], e1[3]), cvtpk(e1[4], e1[5]), cvtpk(e1[6], e1[7])};
        pw3 = (u32x4){cvtpk(e1[8], e1[9]), cvtpk(e1[10], e1[11]), cvtpk(e1[12], e1[13]), cvtpk(e1[14], e1[15])};
        __builtin_amdgcn_sched_barrier(0);
        pv(o, vb0 + slot, __builtin_bit_cast(bf16x8, pw0), __builtin_bit_cast(bf16x8, pw1), __builtin_bit_cast(bf16x8, pw2), __builtin_bit_cast(bf16x8, pw3));
    }
    bf16_t* Ow = O + (rowbase + q0 + wid * 32) * DM + h * HD;
    { __attribute__((address_space(3))) bf16_t* stg = (__attribute__((address_space(3))) bf16_t*)(shm + LOST) + wid * 2048;
#pragma unroll
        for (int r = 0; r < 16; ++r) { const int orow = (r & 3) + 8 * (r >> 2) + 4 * hi;
#pragma unroll
            for (int d0 = 0; d0 < 2; ++d0) stg[orow * 64 + d0 * 32 + r32] = (bf16_t)(cvtpk(o[d0][r], 0.f) & 0xffffu); }
        asm volatile("s_waitcnt lgkmcnt(0)" ::: "memory");
#pragma unroll
        for (int i = 0; i < 4; ++i) { const int row = i * 8 + (lane >> 3), ch = lane & 7; const u32x4 v = *(const __attribute__((address_space(3))) u32x4*)(stg + row * 64 + ch * 8); *(u32x4*)(Ow + (long)row * DM + ch * 8) = v; } }
    asm volatile("s_waitcnt lgkmcnt(0)\n\ts_barrier" ::: "memory");
#undef SBA_DMA_K
#undef SBA_DMA_V
}
#undef SBA_WAIT_BAR
}

constexpr int NWAVES = 8;
#ifndef MK_PER_PHASE
#define MK_PER_PHASE 1
#endif
constexpr int N_PHASES = 16;

constexpr size_t MiB = 1u << 20;
constexpr size_t WS_CTL = 0, CTL_ZERO_BYTES = 1 * MiB;
constexpr size_t WS_ADA_T = 2 * MiB;
constexpr size_t WS_W1IN_T = 20 * MiB;
constexpr size_t WS_W1OUT_T = 31 * MiB;
constexpr size_t WS_WIN_T = 37 * MiB;
constexpr size_t WS_GLU_T = 45 * MiB;
constexpr size_t WS_WA_T = 46 * MiB;
constexpr size_t WS_WB_T = 47 * MiB;
constexpr size_t WS_WOUT_T = 48 * MiB;
constexpr size_t WS_W2IN_T = 50 * MiB;
constexpr size_t WS_W2OUT_T = 61 * MiB;
constexpr size_t WS_SC = 67 * MiB;
constexpr size_t WS_MOD = 68 * MiB;
constexpr size_t WS_END = 73 * MiB;
constexpr size_t WS_U = 80 * MiB;
constexpr size_t WS_HID = 116 * MiB;
constexpr size_t WS_H = 212 * MiB;
constexpr size_t WS_Q = 280 * MiB;
constexpr size_t WS_KB = 298 * MiB, WS_VB = 316 * MiB;
constexpr size_t WS_S = 334 * MiB;
constexpr size_t WS_Y = 368 * MiB;
constexpr size_t WS_GA = 402 * MiB, WS_GB = 436 * MiB;
constexpr size_t WS_OA = 470 * MiB, WS_ZG = 488 * MiB, WS_OB = 506 * MiB;
constexpr size_t WS_TMP = 524 * MiB;
constexpr size_t WS_MRG = 592 * MiB;
constexpr size_t WS_TOTAL = 628 * MiB;
constexpr int CW_BAR = 4096;

constexpr int RING_OFF = 0, RING_BYTES = 131072;
constexpr int LDSCTL_OFF = RING_BYTES, MISC_OFF = LDSCTL_OFF + 320;
constexpr int LDS_BYTES = 147456;

#define GAS __attribute__((address_space(1)))
#define LAS __attribute__((address_space(3)))
typedef unsigned short bf16;
typedef unsigned v4u __attribute__((ext_vector_type(4)));
typedef float f32x4 __attribute__((ext_vector_type(4)));
typedef short bf16x8 __attribute__((ext_vector_type(8)));
typedef GAS unsigned gu32;
typedef GAS unsigned long long gu64;
#define RLX_AGENT __ATOMIC_RELAXED, __HIP_MEMORY_SCOPE_AGENT
#define LDS_WAIT() asm volatile("s_waitcnt lgkmcnt(0)" ::: "memory")
#define VM_WAIT() asm volatile("s_waitcnt vmcnt(0)" ::: "memory")
__device__ __forceinline__ unsigned long long rt() { return __builtin_amdgcn_s_memrealtime(); }
__device__ __forceinline__ unsigned f2bf(float f) { unsigned u = __builtin_bit_cast(unsigned, f); return (u + 0x7fffu + ((u >> 16) & 1u)) >> 16; }
__device__ __forceinline__ unsigned pk2(float lo, float hi) { return f2bf(lo) | (f2bf(hi) << 16); }

#define XB_TMO      128
#define XB_XCNT(j)  (256  + 64 * (j))
#define XB_XSUB(j)  (1280 + 64 * (j))
#define XB_XGEN(j)  (2304 + 64 * (j))
#define XB_TOP      3328
#define XB_TOPGEN   3392
#define XCD_BAR_WORDS 3456
#define XB_SPIN_CAP (1u << 18)

__device__ __forceinline__ unsigned xb_ld(unsigned* p)              { return __hip_atomic_load(p, __ATOMIC_RELAXED, __HIP_MEMORY_SCOPE_AGENT); }
__device__ __forceinline__ unsigned xb_add(unsigned* p, unsigned v) { return __hip_atomic_fetch_add(p, v, __ATOMIC_RELAXED, __HIP_MEMORY_SCOPE_AGENT); }
__device__ __forceinline__ unsigned xb_xcc_id() { return (unsigned)__builtin_amdgcn_s_getreg((3 << 11) | 20) & 0xFu; }
#define XB_SPIN(cond, bar) do { unsigned _sp = 0; while (cond) { __builtin_amdgcn_s_sleep(1); \
    if ((++_sp & 255u) == 0u) { if (xb_ld(&(bar)[XB_TMO])) break; if (_sp > XB_SPIN_CAP) { atomicAdd(&(bar)[XB_TMO], 1u); break; } } } } while (0)

struct XcdBarrier {
    unsigned* bar; unsigned x;
    volatile LAS unsigned* st;
};

__device__ __forceinline__ XcdBarrier xcd_barrier_post(unsigned* bar, volatile LAS unsigned* st) {
    XcdBarrier b; b.bar = bar; b.x = xb_xcc_id(); b.st = st;
    if (threadIdx.x == 0) (void)xb_add(&bar[XB_XCNT(b.x)], 1u);
    return b;
}
__device__ __forceinline__ void xcd_barrier_complete(unsigned* bar, unsigned x, unsigned& nloc, unsigned& nx) {
    const unsigned G = gridDim.x * gridDim.y * gridDim.z;
    unsigned sum, cnt, mine, sp = 0u;
    for (;;) {
        sum = 0u; cnt = 0u; mine = 0u;
#pragma unroll
        for (unsigned j = 0; j < 16; ++j) { const unsigned c = xb_ld(&bar[XB_XCNT(j)]); sum += c; cnt += (c > 0u) ? 1u : 0u; mine = (j == x) ? c : mine; }
        if (sum == G) break;
        __builtin_amdgcn_s_sleep(1);
        if ((++sp & 255u) == 0u) { if (xb_ld(&bar[XB_TMO])) break; if (sp > XB_SPIN_CAP) { atomicAdd(&bar[XB_TMO], 1u); break; } }
    }
    nloc = mine > 0u ? mine : 1u; nx = cnt > 0u ? cnt : 1u;
}

__device__ __forceinline__ void xcd_barrier(const XcdBarrier& b) {
    asm volatile("s_waitcnt vmcnt(0)" ::: "memory");
    __syncthreads();
    if (threadIdx.x == 0) {
        unsigned* bar = b.bar;
        __builtin_amdgcn_s_waitcnt(0);
        unsigned nloc = b.st[0], nx = b.st[1];
        if (nloc == 0u) { xcd_barrier_complete(bar, b.x, nloc, nx); b.st[0] = nloc; b.st[1] = nx; }
        const unsigned old = xb_add(&bar[XB_XSUB(b.x)], 1u);
        const unsigned gen = old / nloc;
        if (old + 1u == (gen + 1u) * nloc) {
            __builtin_amdgcn_fence(__ATOMIC_RELEASE, "agent");
            asm volatile("s_waitcnt vmcnt(0)" ::: "memory");
            const unsigned og = xb_add(&bar[XB_TOP], 1u);
            const unsigned tg = og / nx;
            if (og + 1u == (tg + 1u) * nx) xb_add(&bar[XB_TOPGEN], 1u);
            else XB_SPIN(xb_ld(&bar[XB_TOPGEN]) == tg, bar);
            __builtin_amdgcn_fence(__ATOMIC_ACQUIRE, "agent");
            xb_add(&bar[XB_XGEN(b.x)], 1u);
            asm volatile("s_waitcnt vmcnt(0)" ::: "memory");
        } else {
            XB_SPIN(xb_ld(&bar[XB_XGEN(b.x)]) == gen, bar);
            __builtin_amdgcn_fence(__ATOMIC_ACQUIRE, "agent");
            asm volatile("s_waitcnt vmcnt(0)" ::: "memory");
        }
    }
    __syncthreads();
}

struct Frame {
    LAS unsigned char* lds;
    volatile LAS unsigned* MISC;
    gu32* ctl;
    int tid, lane, wave;
    int vcu, G;
    float* out; unsigned char* ws;
};
__device__ __forceinline__ float wave_sum(float v) {
#pragma unroll
    for (int o = 1; o < 64; o <<= 1) v += __shfl_xor(v, o);
    return v;
}
__device__ __forceinline__ float sigm_f(float x) { return __builtin_amdgcn_rcpf(1.0f + __builtin_amdgcn_exp2f(-x * LOG2E)); }
__device__ __forceinline__ float gelu_tanh(float x) { return x * sigm_f(1.5957691216057308f * (x + 0.044715f * x * x * x)); }
__device__ __forceinline__ unsigned short bf1(float f) { return (unsigned short)f2bf(f); }

__device__ __forceinline__ void transpose_item(const float* W, int K, int N, bf16* WT, int k0, int n0, int dst_row0, LAS float* scr, int lane) {
#pragma unroll 8
    for (int i = 0; i < 32; ++i) { const int kk = 2 * i + (lane >> 5); scr[kk * 33 + (lane & 31)] = W[(size_t)(k0 + kk) * N + n0 + (lane & 31)]; }
    LDS_WAIT(); asm volatile("" ::: "memory");
    const int c = lane & 7;
#pragma unroll
    for (int j = 0; j < 4; ++j) { const int n = (lane >> 3) + 8 * j; const LAS float* s = scr + (8 * c) * 33 + n;
        v4u o; o.x = pk2(s[0 * 33], s[1 * 33]); o.y = pk2(s[2 * 33], s[3 * 33]); o.z = pk2(s[4 * 33], s[5 * 33]); o.w = pk2(s[6 * 33], s[7 * 33]);
        *(GAS v4u*)(WT + (size_t)(dst_row0 + n) * K + k0 + 8 * c) = o; }
    LDS_WAIT(); asm volatile("" ::: "memory");
}
__device__ __forceinline__ void transpose_plain(const float* W, int K, int N, bf16* WT, int item, LAS float* scr, int lane) {
    const int nblk = N / 32, kb = item / nblk, nb = item % nblk; transpose_item(W, K, N, WT, 64 * kb, 32 * nb, 32 * nb, scr, lane);
}
__device__ __forceinline__ void transpose_swiglu(const float* W, bf16* WT, int item, LAS float* scr, int lane) {
    const int N = 2 * FF, nblk = N / 32, kb = item / nblk, nb = item % nblk, n0 = 32 * nb; const int up = n0 >= FF ? 1 : 0, j = n0 - up * FF;
    transpose_item(W, D, N, WT, 64 * kb, n0, 256 * (j / 128) + 128 * up + (j % 128), scr, lane);
}

__device__ __forceinline__ void rmsmod_row(const float* xrow, const float* gain, const float* shift, const float* scale, bf16* orow, int lane) {
    const GAS f32x4* xr = (const GAS f32x4*)xrow + lane;
    f32x4 v[4]; float s = 0.f;
#pragma unroll
    for (int j = 0; j < 4; ++j) { v[j] = xr[64 * j]; s += (v[j].x * v[j].x + v[j].y * v[j].y) + (v[j].z * v[j].z + v[j].w * v[j].w); }
    const float rs = 1.0f / sqrtf(wave_sum(s) * (1.f / D) + RMS_EPS);
    GAS unsigned long long* o8 = (GAS unsigned long long*)orow + lane;
#pragma unroll
    for (int j = 0; j < 4; ++j) { const int c = 4 * lane + 256 * j; const f32x4 g = *(const f32x4*)(gain + c), sc = *(const f32x4*)(scale + c), sh = *(const f32x4*)(shift + c);
        const f32x4 u = v[j] * rs * g * (sc + 1.0f) + sh;
        o8[64 * j] = (unsigned long long)pk2(u.x, u.y) | ((unsigned long long)pk2(u.z, u.w) << 32); }
}
__device__ __forceinline__ void norm_phase(Frame& F, const float* hp, const float* hs, const float* gain, int sh_off, int sc_off) {
    const int gw = F.vcu * NWAVES + F.wave, NGW = F.G * NWAVES; const float* mod = (const float*)(F.ws + WS_MOD); bf16* U = (bf16*)(F.ws + WS_U);
    for (int m = gw; m < M; m += NGW) { const float* mr = mod + (size_t)seq_of_row(m) * NMOD;
        rmsmod_row(m < NP ? hp + (size_t)m * D : hs + (size_t)(m - NP) * D, gain, mr + sh_off, mr + sc_off, U + (size_t)m * D, F.lane); }
}

template <int NK, bool ISNEW>
__device__ __forceinline__ void sattn_tile(const float* kbase, const float* vbase, int lane, float bias2, const LAS float* Qs, LAS float* Ws, float (&C)[8], float (&o)[8]) {
    const int kr = lane < NK ? lane : NK - 1;
    const f32x4* kp = (const f32x4*)(kbase + (size_t)kr * 512);
    f32x4 k[16];
#pragma unroll
    for (int i = 0; i < 16; ++i) k[i] = kp[i];
    float s[8];
#pragma unroll
    for (int q = 0; q < 8; ++q) s[q] = 0.f;
#pragma unroll
    for (int d4 = 0; d4 < 16; ++d4) {
#pragma unroll
        for (int q = 0; q < 8; ++q) { const f32x4 qv = *(const LAS f32x4*)(Qs + q * 64 + d4 * 4); s[q] += (k[d4].x * qv.x + k[d4].y * qv.y) + (k[d4].z * qv.z + k[d4].w * qv.w); }
        if (d4 & 1) __builtin_amdgcn_sched_barrier(0); }
    __builtin_amdgcn_sched_barrier(0);
    float v[NK];
#pragma unroll
    for (int kk = 0; kk < NK; ++kk) v[kk] = vbase[(size_t)kk * 512 + lane];
    __builtin_amdgcn_sched_barrier(0);
    float wq[8];
#pragma unroll
    for (int q = 0; q < 8; ++q) {
        const bool valid = ISNEW ? (lane < q) : true;
        const float z = __builtin_fminf(s[q] + bias2, 60.0f);
        const float E = valid ? __builtin_amdgcn_exp2f(z) : 0.f;
        float r = valid ? __builtin_amdgcn_rcpf(1.0f + E) : 1.0f;
#pragma unroll
        for (int off = 1; off < 64; off <<= 1) { const float y = __shfl_down(r, off); if (lane + off < 64) r *= y; }
        const float tot = __builtin_bit_cast(float, __builtin_amdgcn_readfirstlane(__builtin_bit_cast(int, r)));
        wq[q] = E * r * C[q]; C[q] *= tot;
    }
    *(LAS f32x4*)(Ws + lane * 8) = (f32x4){wq[0], wq[1], wq[2], wq[3]}; *(LAS f32x4*)(Ws + lane * 8 + 4) = (f32x4){wq[4], wq[5], wq[6], wq[7]};
    LDS_WAIT(); asm volatile("" ::: "memory");
#pragma unroll
    for (int kk = 0; kk < NK; ++kk) { const f32x4 w0 = *(const LAS f32x4*)(Ws + kk * 8), w1 = *(const LAS f32x4*)(Ws + kk * 8 + 4);
        o[0] += w0.x * v[kk]; o[1] += w0.y * v[kk]; o[2] += w0.z * v[kk]; o[3] += w0.w * v[kk]; o[4] += w1.x * v[kk]; o[5] += w1.y * v[kk]; o[6] += w1.z * v[kk]; o[7] += w1.w * v[kk];
        if ((kk & 7) == 7) __builtin_amdgcn_sched_barrier(0); }
    LDS_WAIT(); asm volatile("" ::: "memory");
}
__device__ __forceinline__ void sattn_unit(Frame& F, int b, int hg, const float* sb_bias, const float* cache_k, const float* cache_v, const int* ptab) {
    const int w = F.wave, lane = F.lane, h = hg * 4 + (w & 3), half = w >> 2;
    LAS float* Qs = (LAS float*)(F.lds + RING_OFF + w * 4096);
    LAS float* Ws = (LAS float*)(F.lds + RING_OFF + w * 4096 + 2048);
    LAS float* Oc = (LAS float*)(F.lds + RING_OFF + 32768);
    const int row0 = NP + b * ST;
    const bf16* QB = (const bf16*)(F.ws + WS_Q);
    { const int q = lane >> 3, d8 = (lane & 7) * 8; const v4u raw = *(const GAS v4u*)(QB + (size_t)(row0 + q) * HW + h * HD + d8);
      LAS float* dst = Qs + q * 64 + d8;
      *(LAS f32x4*)dst = (f32x4){__builtin_bit_cast(float, raw.x << 16), __builtin_bit_cast(float, raw.x & 0xffff0000u), __builtin_bit_cast(float, raw.y << 16), __builtin_bit_cast(float, raw.y & 0xffff0000u)};
      *(LAS f32x4*)(dst + 4) = (f32x4){__builtin_bit_cast(float, raw.z << 16), __builtin_bit_cast(float, raw.z & 0xffff0000u), __builtin_bit_cast(float, raw.w << 16), __builtin_bit_cast(float, raw.w & 0xffff0000u)}; }
    LDS_WAIT(); asm volatile("" ::: "memory");
    float C[8], o[8];
#pragma unroll
    for (int q = 0; q < 8; ++q) { C[q] = 1.0f; o[q] = 0.f; }
    const float bias2 = sb_bias[h] * LOG2E;
    if (half == 1) sattn_tile<8, true>(F.out + O_KS + (size_t)b * ST * 512 + h * HD, F.out + O_VS + (size_t)b * ST * 512 + h * HD, lane, bias2, Qs, Ws, C, o);
    for (int tt = 15; tt >= 0; --tt) {
        const int pos0 = 1024 * half + 64 * tt; const int page = __builtin_amdgcn_readfirstlane(ptab[b * NPAGES + (pos0 >> 7)]);
        const size_t base = ((size_t)page * PAGE + (pos0 & 127)) * 512 + h * HD;
        sattn_tile<64, false>(cache_k + base, cache_v + base, lane, bias2, Qs, Ws, C, o);
    }
    if (half == 0) {
#pragma unroll
        for (int q = 0; q < 8; ++q) Oc[((w & 3) * 8 + q) * 64 + lane] = o[q]; }
    LDS_WAIT(); __syncthreads();
    if (half == 1) { bf16* OA = (bf16*)(F.ws + WS_OA);
#pragma unroll
        for (int q = 0; q < 8; ++q) { const float r = o[q] + C[q] * Oc[((w & 3) * 8 + q) * 64 + lane]; OA[(size_t)(row0 + q) * HW + h * HD + lane] = bf1(r); } }
    LDS_WAIT(); __syncthreads();
}

constexpr int SSM_WBYTES = 13312, SSM_XPITCH = 136;
struct SsmLane { float ar, ai, lr, li, dt; };
struct SsmPtrs { const float *lre, *lim, *ldt, *bre, *bim, *cre, *cim, *dsk, *s0r, *s0i; };
__device__ __forceinline__ SsmLane ssm_lane(const SsmPtrs& P, int g, int p) {
    SsmLane L; L.lr = P.lre[g * 64 + p]; L.li = P.lim[g * 64 + p]; L.dt = expf(P.ldt[g]);
    const float mag = expf(L.lr * L.dt); float sn, cs; sincosf(L.li * L.dt, &sn, &cs); L.ar = mag * cs; L.ai = mag * sn; return L;
}
__device__ __forceinline__ void ssm_cfrag(const SsmPtrs& P, int g, int lane, pg8::bf16x8 (&cf)[4]) {
    const int h = lane & 15, kq = lane >> 4;
#pragma unroll
    for (int s = 0; s < 4; ++s) { const float* src = (s < 2 ? P.cre : P.cim) + (size_t)(g * 16 + h) * 64 + 32 * (s & 1) + 8 * kq; const float sg = s < 2 ? 1.f : -1.f;
        const f32x4 a = *(const f32x4*)src * sg, b = *(const f32x4*)(src + 4) * sg;
        v4u w; w.x = pk2(a.x, a.y); w.y = pk2(a.z, a.w); w.z = pk2(b.x, b.y); w.w = pk2(b.z, b.w); cf[s] = __builtin_bit_cast(pg8::bf16x8, w); }
}
__device__ __forceinline__ pg8::f32x4 ssm_cproj(const LAS unsigned short* X, int blk, int lane, const pg8::bf16x8 (&cf)[4]) {
    pg8::f32x4 acc = (pg8::f32x4){0.f, 0.f, 0.f, 0.f};
#pragma unroll
    for (int s = 0; s < 4; ++s) { const pg8::bf16x8 a = *(const LAS pg8::bf16x8*)(X + (blk * 16 + (lane & 15)) * SSM_XPITCH + 32 * s + 8 * (lane >> 4));
        acc = __builtin_amdgcn_mfma_f32_16x16x32_bf16(a, cf[s], acc, 0, 0, 0); }
    return acc;
}
template <bool SAMPLE>
__device__ __forceinline__ void ssm_scan_unit(Frame& F, const SsmPtrs& P, int b, int g, int c) {
    const int lane = F.lane, p = lane;
    LAS float* U = (LAS float*)(F.lds + RING_OFF + F.wave * SSM_WBYTES); LAS unsigned short* X = (LAS unsigned short*)(F.lds + RING_OFF + F.wave * SSM_WBYTES + 4096);
    const SsmLane L = ssm_lane(P, g, p);
    const float den = L.lr * L.lr + L.li * L.li, nr = L.ar - 1.0f, ni = L.ai; const float zr = (nr * L.lr + ni * L.li) / den, zi = (ni * L.lr - nr * L.li) / den;
    float bbr[16], bbi[16];
    { const float* br = P.bre + (size_t)(g * 64 + p) * 16; const float* bi = P.bim + (size_t)(g * 64 + p) * 16;
#pragma unroll
      for (int q4 = 0; q4 < 4; ++q4) { const f32x4 r = *(const f32x4*)(br + 4 * q4), i = *(const f32x4*)(bi + 4 * q4);
#pragma unroll
          for (int e = 0; e < 4; ++e) { bbr[4 * q4 + e] = zr * r[e] - zi * i[e]; bbi[4 * q4 + e] = zr * i[e] + zi * r[e]; } } }
    pg8::bf16x8 cf[4]; ssm_cfrag(P, g, lane, cf);
    const float dsk = P.dsk[g * 16 + (lane & 15)];
    const int tok0 = SAMPLE ? NP + b * ST : b * SEQ + c * SSM_T; constexpr int T = SAMPLE ? ST : SSM_T;
    const float* S = (const float*)(F.ws + WS_S);
    if (lane < T) { const f32x4* src = (const f32x4*)(S + (size_t)(tok0 + lane) * HW + g * 16);
#pragma unroll
        for (int q4 = 0; q4 < 4; ++q4) *(LAS f32x4*)(U + lane * 16 + 4 * q4) = src[q4]; }
    LDS_WAIT(); asm volatile("" ::: "memory");
    float xr = 0.f, xi = 0.f;
    if (SAMPLE) { xr = P.s0r[(size_t)(b * NGRP + g) * 64 + p]; xi = P.s0i[(size_t)(b * NGRP + g) * 64 + p]; }
    float* Y = (float*)(F.ws + WS_Y); bf16* ZG = (bf16*)(F.ws + WS_ZG);
#pragma unroll 1
    for (int sub = 0; sub < (SAMPLE ? 1 : 2); ++sub) {
#pragma unroll 4
        for (int tt = 0; tt < (SAMPLE ? ST : 32); ++tt) { const int t = sub * 32 + tt;
            float bur = 0.f, bui = 0.f;
#pragma unroll
            for (int q4 = 0; q4 < 4; ++q4) { const f32x4 u = *(const LAS f32x4*)(U + t * 16 + 4 * q4);
#pragma unroll
                for (int e = 0; e < 4; ++e) { bur += bbr[4 * q4 + e] * u[e]; bui += bbi[4 * q4 + e] * u[e]; } }
            const float nxr = L.ar * xr - L.ai * xi + bur, nxi = L.ar * xi + L.ai * xr + bui; xr = nxr; xi = nxi;
            X[tt * SSM_XPITCH + p] = bf1(xr); X[tt * SSM_XPITCH + 64 + p] = bf1(xi); }
        LDS_WAIT(); asm volatile("" ::: "memory");
#pragma unroll
        for (int blk = 0; blk < (SAMPLE ? 1 : 2); ++blk) { const pg8::f32x4 acc = ssm_cproj(X, blk, lane, cf);
#pragma unroll
            for (int r = 0; r < 4; ++r) { const int t = sub * 32 + blk * 16 + 4 * (lane >> 4) + r, h = lane & 15; const float y = acc[r] + dsk * U[t * 16 + h];
                if (SAMPLE) { if (t < ST) ZG[(size_t)(tok0 + t) * HW + g * 16 + h] = bf1(gelu_tanh(y)); }
                else Y[(size_t)(tok0 + t) * HW + g * 16 + h] = y; } }
        LDS_WAIT(); asm volatile("" ::: "memory");
    }
    if (SAMPLE) { F.out[O_SRS + (size_t)(b * NGRP + g) * 64 + p] = xr; F.out[O_SIS + (size_t)(b * NGRP + g) * 64 + p] = xi; }
    else { float2* E = (float2*)(F.ws + WS_END); E[((size_t)(b * SSM_NCH + c) * NGRP + g) * 64 + p] = make_float2(xr, xi); }
}
__device__ __forceinline__ void ssm_fix_unit(Frame& F, const SsmPtrs& P, int b, int g, int c) {
    const int lane = F.lane, p = lane;
    LAS unsigned short* X = (LAS unsigned short*)(F.lds + RING_OFF + F.wave * SSM_WBYTES + 4096);
    const SsmLane L = ssm_lane(P, g, p);
    const float magT = expf(L.lr * L.dt * (float)SSM_T); float snT, csT; sincosf(L.li * L.dt * (float)SSM_T, &snT, &csT); const float tr = magT * csT, ti = magT * snT;
    const float2* E = (const float2*)(F.ws + WS_END);
    float cr = 0.f, ci = 0.f;
    for (int cc = 0; cc < c; ++cc) { const float2 e = E[((size_t)(b * SSM_NCH + cc) * NGRP + g) * 64 + p]; const float nr = tr * cr - ti * ci + e.x, ni = tr * ci + ti * cr + e.y; cr = nr; ci = ni; }
    if (c == SSM_NCH - 1) { const float2 e = E[((size_t)(b * SSM_NCH + c) * NGRP + g) * 64 + p];
        F.out[O_SRP + (size_t)(b * NGRP + g) * 64 + p] = tr * cr - ti * ci + e.x; F.out[O_SIP + (size_t)(b * NGRP + g) * 64 + p] = tr * ci + ti * cr + e.y; }
    pg8::bf16x8 cf[4]; ssm_cfrag(P, g, lane, cf);
    const int tok0 = b * SEQ + c * SSM_T;
    const float* Y = (const float*)(F.ws + WS_Y); bf16* ZG = (bf16*)(F.ws + WS_ZG);
    float zr = cr, zi = ci;
#pragma unroll 1
    for (int sub = 0; sub < 2; ++sub) {
        if (c > 0) {
#pragma unroll 4
            for (int tt = 0; tt < 32; ++tt) { const float nr = L.ar * zr - L.ai * zi, ni = L.ar * zi + L.ai * zr; zr = nr; zi = ni;
                X[tt * SSM_XPITCH + p] = bf1(zr); X[tt * SSM_XPITCH + 64 + p] = bf1(zi); }
            LDS_WAIT(); asm volatile("" ::: "memory");
        }
#pragma unroll
        for (int blk = 0; blk < 2; ++blk) { pg8::f32x4 acc = (pg8::f32x4){0.f, 0.f, 0.f, 0.f}; if (c > 0) acc = ssm_cproj(X, blk, lane, cf);
#pragma unroll
            for (int r = 0; r < 4; ++r) { const int t = sub * 32 + blk * 16 + 4 * (lane >> 4) + r, h = lane & 15; const size_t idx = (size_t)(tok0 + t) * HW + g * 16 + h;
                ZG[idx] = bf1(gelu_tanh(Y[idx] + acc[r])); } }
        LDS_WAIT(); asm volatile("" ::: "memory");
    }
}

struct Args { const float* in[34]; float* out; unsigned char* ws; int ph_lo, ph_hi, sub, pad; };
__global__ void __launch_bounds__(NWAVES * 64, 2) sbs5_fwd(Args args) {
    extern __shared__ __attribute__((aligned(16))) unsigned char lds[];
    Frame F;
    F.lds = (LAS unsigned char*)lds;
    F.MISC = (volatile LAS unsigned*)(F.lds + MISC_OFF);
    F.tid = threadIdx.x; F.lane = F.tid & 63; F.wave = __builtin_amdgcn_readfirstlane(F.tid >> 6);
    F.G = gridDim.x; { const int bx = blockIdx.x; F.vcu = (F.G % 8 == 0) ? (bx % 8) * (F.G / 8) + bx / 8 : bx; }
    F.ws = args.ws; F.out = args.out; F.ctl = (gu32*)(args.ws + WS_CTL);
    for (int u = F.tid; u < (LDS_BYTES - LDSCTL_OFF) / 4; u += NWAVES * 64) ((LAS unsigned*)(F.lds + LDSCTL_OFF))[u] = 0u;
    __syncthreads();
    XcdBarrier bar; bar.bar = (unsigned*)(F.ctl + CW_BAR); bar.x = 0; bar.st = nullptr;
    if (!MK_PER_PHASE) bar = xcd_barrier_post((unsigned*)(F.ctl + CW_BAR), F.MISC + 8);
    const int lo = args.ph_lo, hi = args.ph_hi;
#ifndef PH_MASK
#define PH_MASK 0xFFFF
#endif
#define IN(k) ((((PH_MASK) >> (k)) & 1) && lo <= (k) && (k) < hi)
#define SEAM(k) do { if (IN(k) && IN((k) + 1)) xcd_barrier(bar); } while (0)
    unsigned char* ws = F.ws;
    const float* MOD = (const float*)(ws + WS_MOD);
    bf16* U = (bf16*)(ws + WS_U); bf16* HID = (bf16*)(ws + WS_HID); float* H = (float*)(ws + WS_H);
    const int gw = F.vcu * NWAVES + F.wave, NGW = F.G * NWAVES;
    const SsmPtrs SP{args.in[17], args.in[18], args.in[19], args.in[20], args.in[21], args.in[22], args.in[23], args.in[24], args.in[6], args.in[7]};

    if (IN(0)) {
        LAS float* scr = (LAS float*)(F.lds + RING_OFF + F.wave * 16384);
        for (int it = gw; it < (D / 64) * (NMOD / 32); it += NGW) transpose_plain(args.in[9], D, NMOD, (bf16*)(ws + WS_ADA_T), it, scr, F.lane);
        for (int r = gw; r < 256; r += NGW) { bf16* o = (bf16*)(ws + WS_SC) + (size_t)r * D;
            const float* c = r < PB ? args.in[2] + (size_t)r * D : args.in[3] + (size_t)(r - PB) * D;
#pragma unroll
            for (int j = 0; j < 4; ++j) { const int col = 4 * F.lane + 256 * j; f32x4 v = (f32x4){0.f, 0.f, 0.f, 0.f};
                if (r < NSEQ) { v = *(const f32x4*)(c + col); v.x *= sigm_f(v.x); v.y *= sigm_f(v.y); v.z *= sigm_f(v.z); v.w *= sigm_f(v.w); }
                *(unsigned long long*)(o + col) = (unsigned long long)pk2(v.x, v.y) | ((unsigned long long)pk2(v.z, v.w) << 32); } }
    }
    SEAM(0);
    if (IN(1)) {
        constexpr int NMODWG = NMOD / 256;
        if ((int)blockIdx.x < NMODWG) {
            pg8::Gemm g{(const bf16*)(ws + WS_SC), (const bf16*)(ws + WS_ADA_T), 256, NMOD, D, nullptr, nullptr}; pg8::StaticOrder S; S.init(256, NMOD, NMODWG, (int)blockIdx.x);
            pg8::EpiMod E{(float*)(ws + WS_MOD), args.in[10]};
            pg8::gemm_phase<pg8::EpiMod, pg8::StaticOrder, true, true>(F.lds + RING_OFF, g, S, E);
        } else {
            LAS float* scr = (LAS float*)(F.lds + RING_OFF + F.wave * 16384);
            const int tw = ((int)blockIdx.x - NMODWG) * NWAVES + F.wave, NTW = (F.G - NMODWG) * NWAVES;
            constexpr int I_FIN = (D / 64) * (2 * FF / 32), I_FOUT = (FF / 64) * (D / 32), I_IN = (D / 64) * (NIN / 32), I_GLU = (HW / 64) * (HW / 32), I_BR = (HW / 64) * (D / 32), I_OUT = (D / 64) * (D / 32);
            constexpr int NITEMS = 2 * I_FIN + 2 * I_FOUT + I_IN + I_GLU + 2 * I_BR + I_OUT;
            for (int it = tw; it < NITEMS; it += NTW) {
                int r = it;
                if (r < I_FIN) { transpose_swiglu(args.in[12], (bf16*)(ws + WS_W1IN_T), r, scr, F.lane); continue; } r -= I_FIN;
                if (r < I_FOUT) { transpose_plain(args.in[13], FF, D, (bf16*)(ws + WS_W1OUT_T), r, scr, F.lane); continue; } r -= I_FOUT;
                if (r < I_IN) { transpose_plain(args.in[15], D, NIN, (bf16*)(ws + WS_WIN_T), r, scr, F.lane); continue; } r -= I_IN;
                if (r < I_GLU) { transpose_plain(args.in[25], HW, HW, (bf16*)(ws + WS_GLU_T), r, scr, F.lane); continue; } r -= I_GLU;
                if (r < I_BR) { transpose_plain(args.in[27], HW, D, (bf16*)(ws + WS_WA_T), r, scr, F.lane); continue; } r -= I_BR;
                if (r < I_BR) { transpose_plain(args.in[28], HW, D, (bf16*)(ws + WS_WB_T), r, scr, F.lane); continue; } r -= I_BR;
                if (r < I_OUT) { transpose_plain(args.in[29], D, D, (bf16*)(ws + WS_WOUT_T), r, scr, F.lane); continue; } r -= I_OUT;
                if (r < I_FIN) { transpose_swiglu(args.in[31], (bf16*)(ws + WS_W2IN_T), r, scr, F.lane); continue; } r -= I_FIN;
                transpose_plain(args.in[32], FF, D, (bf16*)(ws + WS_W2OUT_T), r, scr, F.lane);
            }
        }
    }
    SEAM(1);
    if (IN(2)) norm_phase(F, args.in[0], args.in[1], args.in[11], MOD_SH1, MOD_SC1);
    SEAM(2);
    if (IN(3)) { pg8::Gemm g{U, (const bf16*)(ws + WS_W1IN_T), M, 2 * FF, D, nullptr, nullptr}; pg8::StaticOrder S; S.init(M, 2 * FF, F.G, (int)blockIdx.x);
        pg8::EpiSwiglu E{HID}; pg8::gemm_phase<pg8::EpiSwiglu, pg8::StaticOrder, true, true>(F.lds + RING_OFF, g, S, E); }
    SEAM(3);
    if (IN(4)) { pg8::Gemm g{HID, (const bf16*)(ws + WS_W1OUT_T), M, D, FF, nullptr, nullptr}; pg8::StaticOrder S; S.init(M, D, F.G, (int)blockIdx.x);
        pg8::EpiResid E{args.in[0], args.in[1], H, MOD, MOD_G1, 0.5f}; pg8::gemm_phase<pg8::EpiResid, pg8::StaticOrder, true, true>(F.lds + RING_OFF, g, S, E); }
    SEAM(4);
    if (IN(5)) norm_phase(F, H, H + (size_t)NP * D, args.in[14], MOD_SH2, MOD_SC2);
    SEAM(5);
    if (IN(6)) { pg8::Gemm g{U, (const bf16*)(ws + WS_WIN_T), M, NIN, D, nullptr, nullptr}; pg8::StaticOrder S; S.init(M, NIN, F.G, (int)blockIdx.x);
        pg8::EpiInproj E{(bf16*)(ws + WS_Q), (bf16*)(ws + WS_KB), (bf16*)(ws + WS_VB), (float*)(ws + WS_S), (bf16*)(ws + WS_GA), (bf16*)(ws + WS_GB), F.out};
        pg8::gemm_phase<pg8::EpiInproj, pg8::StaticOrder, true, true>(F.lds + RING_OFF, g, S, E); }
    SEAM(6);
    if (IN(7)) {
#ifndef P7_MASK
#define P7_MASK 7
#endif
        if (P7_MASK & 1) for (int pi = F.vcu; pi < 256; pi += F.G) { const int bh = pi >> 3, s = pi & 7, b = bh >> 3, h = bh & 7; const float bias2 = args.in[16][h] * LOG2E;
            sba::unit(b, h, 15 - s, (const bf16*)(ws + WS_Q), (const bf16*)(ws + WS_KB), (const bf16*)(ws + WS_VB), (bf16*)(ws + WS_OA), bias2, (sba::lds_ptr)(F.lds + RING_OFF));
            sba::unit(b, h, s, (const bf16*)(ws + WS_Q), (const bf16*)(ws + WS_KB), (const bf16*)(ws + WS_VB), (bf16*)(ws + WS_OA), bias2, (sba::lds_ptr)(F.lds + RING_OFF)); }
        __syncthreads();
        if (P7_MASK & 2) for (int ui = F.vcu; ui < 256; ui += F.G) sattn_unit(F, ui >> 1, ui & 1, args.in[16], args.in[4], args.in[5], (const int*)args.in[8]);
        __syncthreads();
        if (P7_MASK & 4) for (int wu = F.vcu; wu < PB * SSM_NCH * 4; wu += F.G) { const int gq = wu & 3, c = (wu >> 2) % SSM_NCH, b = wu / (4 * SSM_NCH); ssm_scan_unit<false>(F, SP, b, gq * 8 + F.wave, c); }
        if (P7_MASK & 4) for (int wu = F.vcu; wu < SB * 4; wu += F.G) ssm_scan_unit<true>(F, SP, wu >> 2, (wu & 3) * 8 + F.wave, 0);
    }
    SEAM(7);
    if (IN(8)) { for (int wu = F.vcu; wu < PB * SSM_NCH * 4; wu += F.G) { const int gq = wu & 3, c = (wu >> 2) % SSM_NCH, b = wu / (4 * SSM_NCH); ssm_fix_unit(F, SP, b, gq * 8 + F.wave, c); } }
    SEAM(8);
    if (IN(9)) { pg8::Gemm g{(const bf16*)(ws + WS_ZG), (const bf16*)(ws + WS_GLU_T), M, HW, HW, nullptr, nullptr}; pg8::StaticOrder S; S.init(M, HW, F.G, (int)blockIdx.x);
        pg8::EpiGlu E{(const bf16*)(ws + WS_ZG), (bf16*)(ws + WS_OB), args.in[26]}; pg8::gemm_phase<pg8::EpiGlu, pg8::StaticOrder, true, true>(F.lds + RING_OFF, g, S, E); }
    SEAM(9);
    if (IN(10)) { pg8::Gemm g{(const bf16*)(ws + WS_OA), (const bf16*)(ws + WS_WA_T), M, D, HW, (const bf16*)(ws + WS_OB), (const bf16*)(ws + WS_WB_T)};
        pg8::EpiBranch E{(const bf16*)(ws + WS_GA), (const bf16*)(ws + WS_GB), (float*)(ws + WS_TMP), (bf16*)(ws + WS_MRG)};
        if (args.sub != 1) { pg8::SelOrder S; S.init(M, D, F.G, (int)blockIdx.x, 0); pg8::gemm_phase<pg8::EpiBranch, pg8::SelOrder, true, true>(F.lds + RING_OFF, g, S, E); }
        if (args.sub < 0) xcd_barrier(bar);
        if (args.sub != 0) { pg8::SelOrder S; S.init(M, D, F.G, (int)blockIdx.x, 1); pg8::gemm_phase<pg8::EpiBranch, pg8::SelOrder, true, true>(F.lds + RING_OFF, g, S, E); } }
    SEAM(10);
    if (IN(11)) { pg8::Gemm g{(const bf16*)(ws + WS_MRG), (const bf16*)(ws + WS_WOUT_T), M, D, D, nullptr, nullptr}; pg8::StaticOrder S; S.init(M, D, F.G, (int)blockIdx.x);
        pg8::EpiResid E{H, H + (size_t)NP * D, H, MOD, MOD_G2, 1.0f}; pg8::gemm_phase<pg8::EpiResid, pg8::StaticOrder, true, true>(F.lds + RING_OFF, g, S, E); }
    SEAM(11);
    if (IN(12)) norm_phase(F, H, H + (size_t)NP * D, args.in[30], MOD_SH3, MOD_SC3);
    SEAM(12);
    if (IN(13)) { pg8::Gemm g{U, (const bf16*)(ws + WS_W2IN_T), M, 2 * FF, D, nullptr, nullptr}; pg8::StaticOrder S; S.init(M, 2 * FF, F.G, (int)blockIdx.x);
        pg8::EpiSwiglu E{HID}; pg8::gemm_phase<pg8::EpiSwiglu, pg8::StaticOrder, true, true>(F.lds + RING_OFF, g, S, E); }
    SEAM(13);
    if (IN(14)) { pg8::Gemm g{HID, (const bf16*)(ws + WS_W2OUT_T), M, D, FF, nullptr, nullptr}; pg8::StaticOrder S; S.init(M, D, F.G, (int)blockIdx.x);
        pg8::EpiResid E{H, H + (size_t)NP * D, H, MOD, MOD_G3, 0.5f}; pg8::gemm_phase<pg8::EpiResid, pg8::StaticOrder, true, true>(F.lds + RING_OFF, g, S, E); }
    SEAM(14);
#ifdef DBG_DUMP
    {
        const bf16* s0 = (const bf16*)(ws + (DBG_DUMP == 1 ? WS_ZG : DBG_DUMP == 2 ? WS_MRG : DBG_DUMP == 3 ? WS_U : DBG_DUMP == 4 ? WS_OA : WS_GA));
        const bf16* s1 = (const bf16*)(ws + (DBG_DUMP == 1 ? WS_OB : DBG_DUMP == 2 ? WS_MRG + (size_t)M * 1024 : DBG_DUMP == 3 ? WS_U + (size_t)M * 1024 : DBG_DUMP == 4 ? WS_OB : WS_GA + (size_t)M * 1024));
        const size_t n = (size_t)M * 512;
        for (size_t i = (size_t)blockIdx.x * 512 + F.tid; i < n; i += (size_t)F.G * 512) { F.out[i] = __builtin_bit_cast(float, (unsigned)s0[i] << 16); F.out[n + i] = __builtin_bit_cast(float, (unsigned)s1[i] << 16); }
    }
#endif
    if (IN(15)) {
        for (int m = gw; m < M; m += NGW) { const GAS f32x4* xr = (const GAS f32x4*)(H + (size_t)m * D) + F.lane; f32x4 v[4]; float s = 0.f;
#pragma unroll
            for (int j = 0; j < 4; ++j) { v[j] = xr[64 * j]; s += (v[j].x * v[j].x + v[j].y * v[j].y) + (v[j].z * v[j].z + v[j].w * v[j].w); }
            const float rs = 1.0f / sqrtf(wave_sum(s) * (1.f / D) + RMS_EPS);
            float* orow = F.out + (m < NP ? O_YP + (size_t)m * D : O_YS + (size_t)(m - NP) * D);
#pragma unroll
            for (int j = 0; j < 4; ++j) { const int c = 4 * F.lane + 256 * j; *(f32x4*)(orow + c) = v[j] * rs * *(const f32x4*)(args.in[33] + c); } }
    }
#undef IN
#undef SEAM
}

extern "C" void kernel_launch(void* const* d_in, const int* in_sizes, int n_in, void* d_out, int out_size, void* d_ws, size_t ws_size, hipStream_t stream) {
    static int grid = 0;
    if (grid == 0) {
        if (n_in != 34 || out_size != (int)O_TOTAL || ws_size < WS_TOTAL) { fprintf(stderr, "kernel_launch: unexpected shapes (n_in %d, out %d, ws %zu); nothing launched\n", n_in, out_size, ws_size); grid = -1; return; }
        int dev = 0, cus = 0, per_cu = 0;
        if (hipGetDevice(&dev) != hipSuccess || hipDeviceGetAttribute(&cus, hipDeviceAttributeMultiprocessorCount, dev) != hipSuccess) { grid = -1; return; }
        if (hipFuncSetAttribute((const void*)sbs5_fwd, hipFuncAttributeMaxDynamicSharedMemorySize, LDS_BYTES) != hipSuccess) { fprintf(stderr, "kernel_launch: hipFuncSetAttribute failed\n"); grid = -1; return; }
        if (hipOccupancyMaxActiveBlocksPerMultiprocessor(&per_cu, (const void*)sbs5_fwd, NWAVES * 64, LDS_BYTES) != hipSuccess || per_cu < 1) { fprintf(stderr, "kernel_launch: occupancy query reports %d workgroups per CU\n", per_cu); }
        (void)hipGetLastError();
        grid = cus;
    }
    if (grid < 0) return;
    (void)hipMemsetAsync((char*)d_ws + WS_CTL, 0, CTL_ZERO_BYTES, stream);
    Args a{};
    for (int i = 0; i < 34; ++i) a.in[i] = (const float*)d_in[i];
    a.out = (float*)d_out; a.ws = (unsigned char*)d_ws;
#if MK_PER_PHASE
    for (int ph = 0; ph < N_PHASES; ++ph) { a.ph_lo = ph; a.ph_hi = ph + 1; a.sub = 0; hipLaunchKernelGGL(sbs5_fwd, dim3(grid), dim3(NWAVES * 64), LDS_BYTES, stream, a);
        if (ph == 10) { a.sub = 1; hipLaunchKernelGGL(sbs5_fwd, dim3(grid), dim3(NWAVES * 64), LDS_BYTES, stream, a); } }
#else
    a.ph_lo = 0; a.ph_hi = N_PHASES; a.sub = -1; hipLaunchKernelGGL(sbs5_fwd, dim3(grid), dim3(NWAVES * 64), LDS_BYTES, stream, a);
#endif
    const hipError_t le = hipPeekAtLastError();
    if (le != hipSuccess) fprintf(stderr, "kernel_launch: launch failed: %s (grid %d)\n", hipGetErrorName(le), grid);
}
```

```cpp
#include <hip/hip_runtime.h>
#include <cstdio>
#include <cstdint>

constexpr int D = 1024, NP = 16384, NS = 1024, M = NP + NS, FF = 2816, NIN = 4096, HW = 512, NSEQ = 132, NMOD = 9216;
constexpr int SEQ = 4096, PB = 4, SB = 128, ST = 8, NHEAD = 8, HD = 64, NGRP = 32, NSTATE = 64, PAST = 2048, PAGE = 128, NPAGES = 16;
constexpr int SSM_T = 64, SSM_NCH = SEQ / SSM_T;
constexpr float RMS_EPS = 1e-6f, LOG2E = 1.4426950408889634f, QSCALE = 0.125f * 1.4426950408889634f;
constexpr int MOD_SH1 = 0, MOD_SC1 = 1024, MOD_G1 = 2048, MOD_SH2 = 3072, MOD_SC2 = 4096, MOD_G2 = 5120, MOD_SH3 = 6144, MOD_SC3 = 7168, MOD_G3 = 8192;
constexpr size_t O_YP = 0, O_YS = 16777216, O_KP = 17825792, O_VP = 26214400, O_SRP = 34603008, O_SIP = 34611200, O_KS = 34619392, O_VS = 35143680, O_SRS = 35667968, O_SIS = 35930112, O_TOTAL = 36192256;
__host__ __device__ __forceinline__ int seq_of_row(int row) { return row < NP ? (row >> 12) : 4 + ((row - NP) >> 3); }
namespace pg8 {
#define PG8_LAS __attribute__((address_space(3)))
typedef unsigned short bf16_t;
typedef short bf16x8 __attribute__((ext_vector_type(8)));
typedef float f32x4 __attribute__((ext_vector_type(4)));
typedef unsigned u32x4 __attribute__((ext_vector_type(4)));
constexpr int BM = 256, BK = 64, HALF = 128, HTB = HALF * BK * 2  , STAGE_BYTES = 8 * HTB, NXCD = 8, WGM = 8;

__host__ __device__ __forceinline__ int lds_byte(int r, int c) { const int st = (r >> 4) * 2 + (c >> 5), rr = r & 15, cc = c & 31, ob = rr * 64 + cc * 2; return st * 1024 + (ob ^ (((ob >> 9) & 1) << 5)); }
__host__ __device__ __forceinline__ void stage_rc(int b, int& R, int& C) { const int st = b / 1024, sb = b % 1024, swz = sb ^ (((sb >> 9) & 1) << 5); R = (st >> 1) * 16 + swz / 64; C = (st & 1) * 32 + (swz % 64) / 2; }
__host__ __device__ __forceinline__ int perm32(int rho) { const int n = rho >> 4, i = rho & 15; return 8 * (i >> 2) + 4 * n + (i & 3); }

struct Unit { int pm, pn, sel; };
struct Gemm { const bf16_t* A; const bf16_t* Bt; int M, N, K; const bf16_t* A2; const bf16_t* Bt2; };

struct StaticOrder {
    int nM, nN, nwg, G, c;
    __host__ __device__ void init(int M, int N, int G_, int c_) { nM = M / BM; nN = N / BM; nwg = nM * nN; G = G_; c = c_; }
    __host__ __device__ bool next(int i, Unit& u) const {
        const long L = (long)i * G + c; if (L >= nwg) return false;
        int wgid = (int)L; { const int q = nwg / NXCD, r = nwg % NXCD, xcd = wgid % NXCD, off = wgid / NXCD; wgid = (xcd < r ? xcd * (q + 1) : r * (q + 1) + (xcd - r) * q) + off; }
        const int nig = WGM * nN, gid = wgid / nig, fm = gid * WGM, gsz = (nM - fm) < WGM ? (nM - fm) : WGM;
        u.pm = fm + ((wgid % nig) % gsz); u.pn = (wgid % nig) / gsz; u.sel = 0; return true;
    }
    __device__ __forceinline__ void a_ready(const Unit&) const {}
    __device__ __forceinline__ void done(const Unit&) const {}
};

typedef float f32x2c __attribute__((ext_vector_type(2))); typedef __bf16 bf16x2c __attribute__((ext_vector_type(2)));
__device__ __forceinline__ unsigned cvt_pk_bf16(float lo, float hi) { f32x2c v = {lo, hi}; bf16x2c b = __builtin_convertvector(v, bf16x2c); return __builtin_bit_cast(unsigned, b); }
typedef float f32x2 __attribute__((ext_vector_type(2)));
__device__ __forceinline__ float sigm(float x) { return __builtin_amdgcn_rcpf(1.0f + __builtin_amdgcn_exp2f(-x * LOG2E)); }
__device__ __forceinline__ float bf_lo(unsigned w) { return __builtin_bit_cast(float, w << 16); }
__device__ __forceinline__ float bf_hi(unsigned w) { return __builtin_bit_cast(float, w & 0xffff0000u); }

struct EpiMod {
    static constexpr bool PERM = false, AFTER_DRAIN = false;
    float* mod; const float* bias;
    __device__ __forceinline__ void operator()(const f32x4 (&acc)[2][2][4][2], const Unit& u, int wr, int wc, int fr, int fq) const {
        const int col0 = u.pn * BM + wc * 32 + 4 * fq;
#pragma unroll
        for (int ai = 0; ai < 2; ++ai)
#pragma unroll
            for (int m = 0; m < 4; ++m) { const int row = u.pm * BM + ai * HALF + wr * 64 + m * 16 + fr;
                if (row < NSEQ) {
#pragma unroll
                    for (int bj = 0; bj < 2; ++bj)
#pragma unroll
                        for (int n = 0; n < 2; ++n) { const int col = col0 + bj * HALF + n * 16;
                            *(f32x4*)(mod + (size_t)row * NMOD + col) = acc[ai][bj][m][n] + *(const f32x4*)(bias + col); } } }
    }
};

struct EpiSwiglu {
    static constexpr bool PERM = true, AFTER_DRAIN = false;
    bf16_t* H;
    __device__ __forceinline__ void operator()(const f32x4 (&acc)[2][2][4][2], const Unit& u, int wr, int wc, int fr, int fq) const {
        const int row0 = u.pm * BM + wr * 64 + fr, col0 = u.pn * HALF + wc * 32 + 8 * fq;
#pragma unroll
        for (int ai = 0; ai < 2; ++ai)
#pragma unroll
            for (int m = 0; m < 4; ++m) { bf16_t* rowp = H + (size_t)(row0 + ai * HALF + m * 16) * FF + col0;
                float o[8];
#pragma unroll
                for (int n = 0; n < 2; ++n)
#pragma unroll
                    for (int e = 0; e < 4; ++e) { const float g = acc[ai][0][m][n][e], up = acc[ai][1][m][n][e]; o[n * 4 + e] = g * sigm(g) * up; }
                u32x4 w; w.x = cvt_pk_bf16(o[0], o[1]); w.y = cvt_pk_bf16(o[2], o[3]); w.z = cvt_pk_bf16(o[4], o[5]); w.w = cvt_pk_bf16(o[6], o[7]);
                *(u32x4*)rowp = w; }
    }
};

struct EpiResid {
    static constexpr bool PERM = false, AFTER_DRAIN = false;
    const float* base_p; const float* base_s; float* out; const float* mod; int goff; float scale;
    __device__ __forceinline__ void operator()(const f32x4 (&acc)[2][2][4][2], const Unit& u, int wr, int wc, int fr, int fq) const {
        const int col0 = u.pn * BM + wc * 32 + 4 * fq;
#pragma unroll
        for (int ai = 0; ai < 2; ++ai)
#pragma unroll
            for (int m = 0; m < 4; ++m) { const int row = u.pm * BM + ai * HALF + wr * 64 + m * 16 + fr;
                const float* bp = (row < NP ? base_p + (size_t)row * D : base_s + (size_t)(row - NP) * D) + col0;
                const float* gp = mod + (size_t)seq_of_row(row) * NMOD + goff + col0; float* op = out + (size_t)row * D + col0;
#pragma unroll
                for (int bj = 0; bj < 2; ++bj)
#pragma unroll
                    for (int n = 0; n < 2; ++n) { const int c = bj * HALF + n * 16;
                        const f32x4 b = *(const f32x4*)(bp + c), g = *(const f32x4*)(gp + c);
                        *(f32x4*)(op + c) = b + (g * scale) * acc[ai][bj][m][n]; } }
    }
};

struct EpiInproj {
    static constexpr bool PERM = true, AFTER_DRAIN = false;
    bf16_t* Q; bf16_t* KB; bf16_t* VB; bf16_t* AU; bf16_t* GA; bf16_t* GB; float* dout;
    __device__ __forceinline__ void operator()(const f32x4 (&acc)[2][2][4][2], const Unit& u, int wr, int wc, int fr, int fq) const {
        const int row0 = u.pm * BM + wr * 64 + fr, ct = wc * 32 + 8 * fq, pn = u.pn;
#pragma unroll
        for (int ai = 0; ai < 2; ++ai)
#pragma unroll
            for (int m = 0; m < 4; ++m) { const int row = row0 + ai * HALF + m * 16;
#pragma unroll
                for (int bj = 0; bj < 2; ++bj) { const f32x4 v0 = acc[ai][bj][m][0], v1 = acc[ai][bj][m][1];
                    if (pn < 2) { const int col = pn * BM + bj * HALF + ct; const f32x4 a = v0 * QSCALE, b = v1 * QSCALE;
                        u32x4 w; w.x = cvt_pk_bf16(a[0], a[1]); w.y = cvt_pk_bf16(a[2], a[3]); w.z = cvt_pk_bf16(b[0], b[1]); w.w = cvt_pk_bf16(b[2], b[3]);
                        *(u32x4*)(Q + (size_t)row * HW + col) = w;
                    } else if (pn < 6) { const bool isk = pn < 4; const int col = (pn - (isk ? 2 : 4)) * BM + bj * HALF + ct;
                        float* fo = dout + (row < NP ? (isk ? O_KP : O_VP) + (size_t)row * HW : (isk ? O_KS : O_VS) + (size_t)(row - NP) * HW) + col;
                        *(f32x4*)fo = v0; *(f32x4*)(fo + 4) = v1;
                        u32x4 w; w.x = cvt_pk_bf16(v0[0], v0[1]); w.y = cvt_pk_bf16(v0[2], v0[3]); w.z = cvt_pk_bf16(v1[0], v1[1]); w.w = cvt_pk_bf16(v1[2], v1[3]);
                        *(u32x4*)((isk ? KB : VB) + (size_t)row * HW + col) = w;
                    } else if (pn < 8) { const int col = (pn - 6) * BM + bj * HALF + ct;
                        const int g = col >> 4, bb = row >> 12, cch = (row >> 6) & 63, tt = row & 63;
                        u32x4 w; w.x = cvt_pk_bf16(v0[0], v0[1]); w.y = cvt_pk_bf16(v0[2], v0[3]); w.z = cvt_pk_bf16(v1[0], v1[1]); w.w = cvt_pk_bf16(v1[2], v1[3]);
                        *(u32x4*)(AU + ((size_t)((g * 4 + bb) * 64 + cch)) * 1024 + tt * 16 + (col & 15)) = w;
                    } else { const bool isa = pn < 12; const int col = (pn - (isa ? 8 : 12)) * BM + bj * HALF + ct;
                        u32x4 w; w.x = cvt_pk_bf16(sigm(v0[0]), sigm(v0[1])); w.y = cvt_pk_bf16(sigm(v0[2]), sigm(v0[3])); w.z = cvt_pk_bf16(sigm(v1[0]), sigm(v1[1])); w.w = cvt_pk_bf16(sigm(v1[2]), sigm(v1[3]));
                        *(u32x4*)((isa ? GA : GB) + (size_t)row * D + col) = w; } } }
    }
};

struct EpiGlu {
    static constexpr bool PERM = true, AFTER_DRAIN = false;
    const bf16_t* ZG; bf16_t* OB; const float* bias;
    __device__ __forceinline__ void operator()(const f32x4 (&acc)[2][2][4][2], const Unit& u, int wr, int wc, int fr, int fq) const {
        const int row0 = u.pm * BM + wr * 64 + fr, col0 = u.pn * BM + wc * 32 + 8 * fq;
#pragma unroll
        for (int ai = 0; ai < 2; ++ai)
#pragma unroll
            for (int m = 0; m < 4; ++m) { const int row = row0 + ai * HALF + m * 16;
#pragma unroll
                for (int bj = 0; bj < 2; ++bj) { const int col = col0 + bj * HALF;
                    const f32x4 v0 = acc[ai][bj][m][0] + *(const f32x4*)(bias + col), v1 = acc[ai][bj][m][1] + *(const f32x4*)(bias + col + 4);
                    const u32x4 z = *(const u32x4*)(ZG + (size_t)row * HW + col);
                    u32x4 w; w.x = cvt_pk_bf16(bf_lo(z.x) * sigm(v0[0]), bf_hi(z.x) * sigm(v0[1])); w.y = cvt_pk_bf16(bf_lo(z.y) * sigm(v0[2]), bf_hi(z.y) * sigm(v0[3]));
                    w.z = cvt_pk_bf16(bf_lo(z.z) * sigm(v1[0]), bf_hi(z.z) * sigm(v1[1])); w.w = cvt_pk_bf16(bf_lo(z.w) * sigm(v1[2]), bf_hi(z.w) * sigm(v1[3]));
                    *(u32x4*)(OB + (size_t)row * HW + col) = w; } }
    }
};

struct EpiBranch {
    static constexpr bool PERM = true, AFTER_DRAIN = false;
    const bf16_t* GA; const bf16_t* GB; float* TMP; bf16_t* MRG;
    __device__ __forceinline__ void operator()(const f32x4 (&acc)[2][2][4][2], const Unit& u, int wr, int wc, int fr, int fq) const {
        const int row0 = u.pm * BM + wr * 64 + fr, col0 = u.pn * BM + wc * 32 + 8 * fq; const bool second = u.sel != 0;
#pragma unroll
        for (int ai = 0; ai < 2; ++ai)
#pragma unroll
            for (int m = 0; m < 4; ++m) { const int row = row0 + ai * HALF + m * 16;
#pragma unroll
                for (int bj = 0; bj < 2; ++bj) { const int col = col0 + bj * HALF; const size_t off = (size_t)row * D + col;
                    const u32x4 gz = *(const u32x4*)((second ? GB : GA) + off);
                    f32x4 g0 = (f32x4){bf_lo(gz.x), bf_hi(gz.x), bf_lo(gz.y), bf_hi(gz.y)}, g1 = (f32x4){bf_lo(gz.z), bf_hi(gz.z), bf_lo(gz.w), bf_hi(gz.w)};
                    f32x4 t0 = g0 * acc[ai][bj][m][0], t1 = g1 * acc[ai][bj][m][1];
                    if (!second) { *(f32x4*)(TMP + off) = t0; *(f32x4*)(TMP + off + 4) = t1; }
                    else { t0 += *(const f32x4*)(TMP + off); t1 += *(const f32x4*)(TMP + off + 4);
                        u32x4 w; w.x = cvt_pk_bf16(t0[0], t0[1]); w.y = cvt_pk_bf16(t0[2], t0[3]); w.z = cvt_pk_bf16(t1[0], t1[1]); w.w = cvt_pk_bf16(t1[2], t1[3]);
                        *(u32x4*)(MRG + off) = w; } } }
    }
};

struct SelOrder {
    StaticOrder so; int sel;
    __device__ void init(int M_, int N_, int G_, int c_, int sel_) { so.init(M_, N_, G_, c_); sel = sel_; }
    __device__ bool next(int i, Unit& u) const { if (!so.next(i, u)) return false; u.sel = sel; return true; }
    __device__ __forceinline__ void a_ready(const Unit&) const {}
    __device__ __forceinline__ void done(const Unit&) const {}
};
struct PairOrder {
    StaticOrder so;
    __device__ void init(int M_, int N_, int G_, int c_) { so.init(M_, N_, G_, c_); }
    __device__ bool next(int i, Unit& u) const { if (!so.next(i >> 1, u)) return false; u.sel = i & 1; return true; }
    __device__ __forceinline__ void a_ready(const Unit&) const {}
    __device__ __forceinline__ void done(const Unit&) const {}
};
template <class Epi, class Sched, bool ALIGN_EPI = false, bool SP2 = false>
__device__ __forceinline__ void gemm_phase(PG8_LAS unsigned char* lds, const Gemm g, const Sched& S, const Epi& E) {
    const int tid = threadIdx.x, wid = __builtin_amdgcn_readfirstlane(tid >> 6), lane = tid & 63, wr = wid >> 2, wc = wid & 3, fr = lane & 15, fq = lane >> 4;
    const int K = g.K, nt = K / BK;
    unsigned voffA[2], voffB[2];
#pragma unroll
    for (int i = 0; i < 2; ++i) { int R, C; stage_rc(tid * 16 + i * 8192, R, C); const int Rb = Epi::PERM ? ((R & ~31) + perm32(R & 31)) : R;
        voffA[i] = (unsigned)(R * K + C) * 2u; voffB[i] = (unsigned)(Rb * K + C) * 2u; }
    const size_t kstep = (size_t)(BK * 2);
    const size_t hstep = (size_t)HALF * K * 2;
    const size_t tstep = 2 * hstep;
    const unsigned ldsw = (unsigned)wid * 1024u;
    const int aoff = lds_byte(wr * 64 + fr, fq * 8), boff = lds_byte(wc * 32 + fr, fq * 8);
#define PG8_SA(b, h) (((b) * 2 + (h)) * HTB)
#define PG8_SB(b, h) ((4 + (b) * 2 + (h)) * HTB)
#define PG8_STAGE(bufoff, gbase, voff) do { _Pragma("unroll") for (int _i = 0; _i < 2; ++_i) \
        __builtin_amdgcn_global_load_lds((const unsigned*)((const char*)(gbase) + (voff)[_i]), (PG8_LAS unsigned*)(lds + (bufoff) + ldsw + _i * 8192), 16, 0, 0); } while (0)
#define PG8_LDA(dst, b, h) do { _Pragma("unroll") for (int m = 0; m < 4; ++m) _Pragma("unroll") for (int k = 0; k < 2; ++k) dst[m][k] = *(const PG8_LAS bf16x8*)(lds + PG8_SA(b, h) + aoff + m * 2048 + k * 1024); } while (0)
#define PG8_LDB(dst, b, h) do { _Pragma("unroll") for (int n = 0; n < 2; ++n) _Pragma("unroll") for (int k = 0; k < 2; ++k) dst[n][k] = *(const PG8_LAS bf16x8*)(lds + PG8_SB(b, h) + boff + n * 2048 + k * 1024); } while (0)
#define PG8_MMA(ai, bj, At, Bt) do { __builtin_amdgcn_s_setprio(1); _Pragma("unroll") for (int m = 0; m < 4; ++m) _Pragma("unroll") for (int n = 0; n < 2; ++n) _Pragma("unroll") for (int k = 0; k < 2; ++k) \
        acc[ai][bj][m][n] = __builtin_amdgcn_mfma_f32_16x16x32_bf16(Bt[n][k], At[m][k], acc[ai][bj][m][n], 0, 0, 0); __builtin_amdgcn_s_setprio(0); } while (0)
#define PG8_WAIT_V(n) asm volatile("s_waitcnt vmcnt(" #n ")" ::: "memory")
#define PG8_WAIT_L(n) asm volatile("s_waitcnt lgkmcnt(" #n ")" ::: "memory")
#define PG8_BAR __builtin_amdgcn_s_barrier()
#define PG8_SCHED __builtin_amdgcn_sched_barrier(0)
    Unit cur, nxt; int ui = 0;
    if (!S.next(0, cur)) return;
    f32x4 acc[2][2][4][2];
#pragma unroll
    for (int a = 0; a < 2; ++a)
#pragma unroll
        for (int b = 0; b < 2; ++b)
#pragma unroll
            for (int m = 0; m < 4; ++m)
#pragma unroll
                for (int n = 0; n < 2; ++n) acc[a][b][m][n] = (f32x4){0.f, 0.f, 0.f, 0.f};
    bf16x8 At[4][2], B0[2][2], B1[2][2];
    const char* cA = (const char*)(cur.sel ? g.A2 : g.A) + (size_t)cur.pm * tstep; const char* cB = (const char*)(cur.sel ? g.Bt2 : g.Bt) + (size_t)cur.pn * tstep;
    S.a_ready(cur);
    if constexpr (SP2) {
        PG8_STAGE(PG8_SB(0, 0), cB, voffB); PG8_STAGE(PG8_SB(0, 1), cB + hstep, voffB); PG8_STAGE(PG8_SA(0, 0), cA, voffA); PG8_STAGE(PG8_SA(0, 1), cA + hstep, voffA);
        if (wr == 1) PG8_BAR;
        PG8_WAIT_V(2); PG8_BAR;
        PG8_STAGE(PG8_SB(1, 0), cB + kstep, voffB); PG8_STAGE(PG8_SA(1, 0), cA + kstep, voffA); PG8_STAGE(PG8_SB(1, 1), cB + hstep + kstep, voffB);
        PG8_WAIT_V(6); PG8_BAR;
    } else {
        PG8_STAGE(PG8_SB(0, 0), cB, voffB); PG8_STAGE(PG8_SA(0, 0), cA, voffA); PG8_STAGE(PG8_SB(0, 1), cB + hstep, voffB); PG8_STAGE(PG8_SA(0, 1), cA + hstep, voffA);
        if (wr == 1) PG8_BAR;
        PG8_WAIT_V(4); PG8_BAR;
        PG8_STAGE(PG8_SB(1, 0), cB + kstep, voffB); PG8_STAGE(PG8_SA(1, 0), cA + kstep, voffA); PG8_STAGE(PG8_SB(1, 1), cB + hstep + kstep, voffB);
        PG8_WAIT_V(6); PG8_BAR;
    }
    for (;;) {
        const bool has_next = S.next(ui + 1, nxt);
        const char* nA = has_next ? (const char*)(nxt.sel ? g.A2 : g.A) + (size_t)nxt.pm * tstep : cA; const char* nB = has_next ? (const char*)(nxt.sel ? g.Bt2 : g.Bt) + (size_t)nxt.pn * tstep : cB;
        for (int t = 0; t < nt; t += 2) {
            const bool last = (t == nt - 2);
            const char* a1 = cA + (size_t)(t + 1) * kstep;
            const char* a2 = last ? nA : cA + (size_t)(t + 2) * kstep; const char* b2 = last ? nB : cB + (size_t)(t + 2) * kstep;
            const char* a3 = a2 + kstep; const char* b3 = b2 + kstep;
            if (last && has_next) S.a_ready(nxt);
            if constexpr (SP2) {
            PG8_LDB(B0, 0, 0); PG8_LDB(B1, 0, 1); PG8_SCHED; PG8_LDA(At, 0, 0); PG8_STAGE(PG8_SA(1, 1), a1 + hstep, voffA);
            PG8_WAIT_V(8); PG8_WAIT_L(0); PG8_BAR; PG8_MMA(0, 0, At, B0); PG8_MMA(0, 1, At, B1); PG8_BAR; PG8_SCHED;
            PG8_LDA(At, 0, 1); PG8_STAGE(PG8_SB(0, 0), b2, voffB); PG8_STAGE(PG8_SB(0, 1), b2 + hstep, voffB); PG8_STAGE(PG8_SA(0, 0), a2, voffA);
            PG8_WAIT_V(8); PG8_WAIT_L(0); PG8_BAR; PG8_MMA(1, 0, At, B0); PG8_MMA(1, 1, At, B1); PG8_BAR; PG8_SCHED;
            PG8_LDB(B0, 1, 0); PG8_LDB(B1, 1, 1); PG8_SCHED; PG8_LDA(At, 1, 0); PG8_STAGE(PG8_SA(0, 1), a2 + hstep, voffA);
            PG8_WAIT_V(8); PG8_WAIT_L(0); PG8_BAR; PG8_MMA(0, 0, At, B0); PG8_MMA(0, 1, At, B1); PG8_BAR; PG8_SCHED;
            PG8_LDA(At, 1, 1); PG8_STAGE(PG8_SB(1, 0), b3, voffB); PG8_STAGE(PG8_SB(1, 1), b3 + hstep, voffB); PG8_STAGE(PG8_SA(1, 0), a3, voffA);
            PG8_WAIT_V(8); PG8_WAIT_L(0); PG8_BAR; PG8_MMA(1, 0, At, B0); PG8_MMA(1, 1, At, B1); PG8_BAR; PG8_SCHED;
            } else {
            PG8_LDB(B0, 0, 0); PG8_SCHED; PG8_LDA(At, 0, 0); PG8_STAGE(PG8_SA(1, 1), a1 + hstep, voffA);
            PG8_WAIT_L(8); PG8_BAR; PG8_WAIT_L(0); PG8_MMA(0, 0, At, B0); PG8_BAR; PG8_SCHED;
            PG8_LDB(B1, 0, 1); PG8_STAGE(PG8_SB(0, 0), b2, voffB);
            PG8_BAR; PG8_WAIT_L(0); PG8_MMA(0, 1, At, B1); PG8_BAR;
            PG8_LDA(At, 0, 1); PG8_STAGE(PG8_SA(0, 0), a2, voffA);
            PG8_BAR; PG8_WAIT_L(0); PG8_MMA(1, 0, At, B0); PG8_BAR; PG8_SCHED;
            PG8_STAGE(PG8_SB(0, 1), b2 + hstep, voffB);
            PG8_WAIT_V(6); PG8_BAR; PG8_MMA(1, 1, At, B1); PG8_BAR;
            PG8_LDB(B0, 1, 0); PG8_SCHED; PG8_LDA(At, 1, 0); PG8_STAGE(PG8_SA(0, 1), a2 + hstep, voffA);
            PG8_WAIT_L(8); PG8_BAR; PG8_WAIT_L(0); PG8_MMA(0, 0, At, B0); PG8_BAR; PG8_SCHED;
            PG8_LDB(B1, 1, 1); PG8_STAGE(PG8_SB(1, 0), b3, voffB);
            PG8_BAR; PG8_WAIT_L(0); PG8_MMA(0, 1, At, B1); PG8_BAR;
            PG8_LDA(At, 1, 1); PG8_STAGE(PG8_SA(1, 0), a3, voffA);
            PG8_BAR; PG8_WAIT_L(0); PG8_MMA(1, 0, At, B0); PG8_BAR; PG8_SCHED;
            PG8_STAGE(PG8_SB(1, 1), b3 + hstep, voffB);
            PG8_WAIT_V(6); PG8_BAR; PG8_MMA(1, 1, At, B1); PG8_BAR;
            }
        }
        if constexpr (ALIGN_EPI) { if (wr == 0) PG8_BAR; }
        if constexpr (!Epi::AFTER_DRAIN) { E(acc, cur, wr, wc, fr, fq); S.done(cur); }
        if (!has_next) break;
#pragma unroll
        for (int a = 0; a < 2; ++a)
#pragma unroll
            for (int b = 0; b < 2; ++b)
#pragma unroll
                for (int m = 0; m < 4; ++m)
#pragma unroll
                    for (int n = 0; n < 2; ++n) acc[a][b][m][n] = (f32x4){0.f, 0.f, 0.f, 0.f};
        cur = nxt; cA = nA; cB = nB; ++ui;
        if constexpr (ALIGN_EPI) { if (wr == 1) PG8_BAR; }
    }
    PG8_WAIT_V(0);
    if constexpr (!ALIGN_EPI) { if (wr == 0) PG8_BAR; }
    PG8_BAR;
    if constexpr (Epi::AFTER_DRAIN) { E.fused(acc, cur, wr, wc, fr, fq, lds, wid, lane); S.done(cur); }
#undef PG8_SA
#undef PG8_SB
#undef PG8_STAGE
#undef PG8_LDA
#undef PG8_LDB
#undef PG8_MMA
#undef PG8_WAIT_V
#undef PG8_WAIT_L
#undef PG8_BAR
#undef PG8_SCHED
}
}

namespace sba {
typedef short bf16x8 __attribute__((ext_vector_type(8)));
typedef short s16x4 __attribute__((ext_vector_type(4)));
typedef float f32x16 __attribute__((ext_vector_type(16)));
typedef unsigned u32x4 __attribute__((ext_vector_type(4)));
typedef unsigned short bf16_t;
typedef __attribute__((address_space(3))) const char* lds_cptr;
typedef __attribute__((address_space(3))) char* lds_ptr;
constexpr int DM = 512, SLOTB = 8192, LK = 0, LV = 2 * SLOTB, LOST = 4 * SLOTB, LBYTES = LOST + 8 * 4096;
__device__ __forceinline__ void glds16(const void* gsrc, unsigned lds_dst) { unsigned keep;
    asm volatile("s_mov_b32 %0, m0\n\ts_mov_b32 m0, %2\n\ts_nop 0\n\tglobal_load_lds_dwordx4 %1, off\n\ts_mov_b32 m0, %0" : "=&s"(keep) : "v"(gsrc), "s"(lds_dst) : "memory"); }
typedef float f32x2_t __attribute__((ext_vector_type(2))); typedef __bf16 bf16x2_t __attribute__((ext_vector_type(2)));
__device__ __forceinline__ unsigned cvtpk(float lo, float hi) { f32x2_t v = {lo, hi}; bf16x2_t b = __builtin_convertvector(v, bf16x2_t); return __builtin_bit_cast(unsigned, b); }
#define SBA_WAIT_BAR() asm volatile("s_waitcnt vmcnt(0) lgkmcnt(0)\n\ts_barrier" ::: "memory")

__device__ __forceinline__ void qkt(f32x16& p0, f32x16& p1, lds_cptr kp, const bf16x8* qr, const f32x16& cin) {
#pragma unroll
    for (int d0 = 0; d0 < 4; ++d0) {
        const bf16x8 b0 = *(const __attribute__((address_space(3))) bf16x8*)(kp + d0 * 2048);
        const bf16x8 b1 = *(const __attribute__((address_space(3))) bf16x8*)(kp + d0 * 2048 + 512);
        if (d0 == 0) { p0 = __builtin_amdgcn_mfma_f32_32x32x16_bf16(b0, qr[0], cin, 0, 0, 0); p1 = __builtin_amdgcn_mfma_f32_32x32x16_bf16(b1, qr[0], cin, 0, 0, 0); }
        else { p0 = __builtin_amdgcn_mfma_f32_32x32x16_bf16(b0, qr[d0], p0, 0, 0, 0); p1 = __builtin_amdgcn_mfma_f32_32x32x16_bf16(b1, qr[d0], p1, 0, 0, 0); } }
}
__device__ __forceinline__ void pv(f32x16* o, int vb, bf16x8 pa0, bf16x8 pa1, bf16x8 pa2, bf16x8 pa3) {
#pragma unroll
    for (int d0 = 0; d0 < 2; ++d0) { s16x4 lo[4], hi[4];
#pragma unroll
        for (int ks = 0; ks < 4; ++ks) {
            asm volatile("ds_read_b64_tr_b16 %0,%1 offset:%c2" : "=&v"(lo[ks]) : "v"(vb), "i"(d0 * 4096 + ks * 1024) : "memory");
            asm volatile("ds_read_b64_tr_b16 %0,%1 offset:%c2" : "=&v"(hi[ks]) : "v"(vb), "i"(d0 * 4096 + ks * 1024 + 512) : "memory"); }
        asm volatile("s_waitcnt lgkmcnt(0)" ::: "memory"); __builtin_amdgcn_sched_barrier(0);
#define SBA_PK(k) (bf16x8){lo[k][0], lo[k][1], lo[k][2], lo[k][3], hi[k][0], hi[k][1], hi[k][2], hi[k][3]}
        o[d0] = __builtin_amdgcn_mfma_f32_32x32x16_bf16(pa0, SBA_PK(0), o[d0], 0, 0, 0);
        o[d0] = __builtin_amdgcn_mfma_f32_32x32x16_bf16(pa1, SBA_PK(1), o[d0], 0, 0, 0);
        o[d0] = __builtin_amdgcn_mfma_f32_32x32x16_bf16(pa2, SBA_PK(2), o[d0], 0, 0, 0);
        o[d0] = __builtin_amdgcn_mfma_f32_32x32x16_bf16(pa3, SBA_PK(3), o[d0], 0, 0, 0);
#undef SBA_PK
    }
}
template <bool MASK>
__device__ __forceinline__ void tile_compute(lds_cptr kp, int vb, const bf16x8* qr, const f32x16& cin, f32x16* o, float& C, int hi, int kbase, int qrel) {
        f32x16 p0, p1;
        qkt(p0, p1, kp, qr, cin);
#pragma unroll
        for (int r = 0; r < 16; ++r) { p0[r] = __builtin_fminf(p0[r], 60.0f); p1[r] = __builtin_fminf(p1[r], 60.0f); }
        if (MASK) { const int kb = kbase + 4 * hi;
#pragma unroll
            for (int r = 0; r < 16; ++r) { const int kv = kb + (r & 3) + 8 * (r >> 2); if (kv >= qrel) p0[r] = -__builtin_inff(); if (kv + 32 >= qrel) p1[r] = -__builtin_inff(); } }
        f32x16 e0, e1;
#pragma unroll
        for (int r = 0; r < 16; ++r) { e0[r] = __builtin_amdgcn_exp2f(p0[r]); e1[r] = __builtin_amdgcn_exp2f(p1[r]); }
#pragma unroll
        for (int r = 0; r < 16; ++r) { p0[r] = __builtin_amdgcn_rcpf(1.0f + e0[r]); p1[r] = __builtin_amdgcn_rcpf(1.0f + e1[r]); }
        float cgprev = 1.0f;
#pragma unroll
        for (int L = 0; L < 8; ++L) {
            f32x16& R = (L < 4) ? p1 : p0; f32x16& E = (L < 4) ? e1 : e0; const int g4 = 4 * (3 - (L & 3));
            R[g4 + 2] *= R[g4 + 3]; R[g4 + 1] *= R[g4 + 2]; R[g4 + 0] *= R[g4 + 1];
            const float cg = cgprev * R[g4 + 0];
            auto rr = __builtin_amdgcn_permlane32_swap(__float_as_uint(cg), __float_as_uint(cgprev), false, false);
            const float mL = hi ? __uint_as_float(rr[0]) : __uint_as_float(rr[1]);
            const float pre = (C * cgprev) * mL;
            E[g4 + 3] *= R[g4 + 3] * pre; E[g4 + 2] *= R[g4 + 2] * pre; E[g4 + 1] *= R[g4 + 1] * pre; E[g4 + 0] *= R[g4 + 0] * pre;
            cgprev = cg;
        }
        { auto rr = __builtin_amdgcn_permlane32_swap(__float_as_uint(cgprev), __float_as_uint(cgprev), false, false); C = C * (__uint_as_float(rr[0]) * __uint_as_float(rr[1])); }
        u32x4 pw0, pw1, pw2, pw3;
        pw0 = (u32x4){cvtpk(e0[0], e0[1]), cvtpk(e0[2], e0[3]), cvtpk(e0[4], e0[5]), cvtpk(e0[6], e0[7])};
        pw1 = (u32x4){cvtpk(e0[8], e0[9]), cvtpk(e0[10], e0[11]), cvtpk(e0[12], e0[13]), cvtpk(e0[14], e0[15])};
        pw2 = (u32x4){cvtpk(e1[0], e1[1]), cvtpk(e1[2], e1[3]), cvtpk(e1[4], e1[5]), cvtpk(e1[6], e1[7])};
        pw3 = (u32x4){cvtpk(e1[8], e1[9]), cvtpk(e1[10], e1[11]), cvtpk(e1[12], e1[13]), cvtpk(e1[14], e1[15])};
        __builtin_amdgcn_sched_barrier(0);
        pv(o, vb, __builtin_bit_cast(bf16x8, pw0), __builtin_bit_cast(bf16x8, pw1), __builtin_bit_cast(bf16x8, pw2), __builtin_bit_cast(bf16x8, pw3));
}
__device__ __forceinline__ void unit(int b, int h, int qb, const bf16_t* Q, const bf16_t* __restrict__ K, const bf16_t* __restrict__ V, bf16_t* O, float bias2, lds_ptr shm) {
    const int tid = threadIdx.x, lane = tid & 63, r32 = lane & 31, hi = lane >> 5; const int wid = __builtin_amdgcn_readfirstlane(tid >> 6);
    const long rowbase = (long)b * SEQ; const int q0 = qb * 256;
    const bf16_t* Qw = Q + (rowbase + q0 + wid * 32) * DM + h * HD;
    const bf16_t* Kh = K + rowbase * DM + h * HD, * Vh = V + rowbase * DM + h * HD;
    const unsigned lds0 = (unsigned)(uintptr_t)shm;
    const bf16_t* ksrc = Kh + (long)lane * DM + wid * 8;
    const bf16_t* vsrc = Vh + (long)(16 * (wid & 3) + (lane >> 2)) * DM + (wid >> 2) * 32 + (lane & 3) * 8;
    const unsigned kdst = lds0 + LK + wid * 1024, vdst = lds0 + LV + wid * 1024;
#define SBA_DMA_K(t, slot) glds16(ksrc + (long)(t) * 64 * DM, (unsigned)__builtin_amdgcn_readfirstlane(kdst + (slot)))
#define SBA_DMA_V(t, slot) glds16(vsrc + (long)(t) * 64 * DM, (unsigned)__builtin_amdgcn_readfirstlane(vdst + (slot)))
    const int vb0 = (int)(lds0 + LV) + ((lane >> 4) & 1) * 32 + (lane & 3) * 8 + (4 * hi + ((lane & 15) >> 2)) * 64;
    const lds_cptr kp0 = (lds_cptr)shm + LK + hi * 1024 + r32 * 16;
    const int NT = (q0 + 256) / 64;
    SBA_DMA_K(NT - 1, ((NT - 1) & 1) * SLOTB); SBA_DMA_V(NT - 1, ((NT - 1) & 1) * SLOTB);
    bf16x8 qr[4];
#pragma unroll
    for (int d0 = 0; d0 < 4; ++d0) qr[d0] = *reinterpret_cast<const bf16x8*>(&Qw[(long)r32 * DM + d0 * 16 + hi * 8]);
    f32x16 o[2]; o[0] = f32x16{}; o[1] = f32x16{};
    f32x16 cin;
#pragma unroll
    for (int r = 0; r < 16; ++r) cin[r] = bias2;
    float C = 1.0f;
    const int qrel = wid * 32 + r32;
    for (int t = NT - 1; t >= 0; --t) {
        const int slot = (t & 1) * SLOTB;
        SBA_WAIT_BAR();
        if (t > 0) { SBA_DMA_K(t - 1, slot ^ SLOTB); SBA_DMA_V(t - 1, slot ^ SLOTB); }
        const int jb = t - (NT - 4);
        if (jb >= 0 && 64 * jb >= 32 * wid + 32) continue;
        if (jb >= 0) tile_compute<true>(kp0 + slot, vb0 + slot, qr, cin, o, C, hi, 64 * jb, qrel); else tile_compute<false>(kp0 + slot, vb0 + slot, qr, cin, o, C, hi, 0, qrel);
    }
    bf16_t* Ow = O + (rowbase + q0 + wid * 32) * DM + h * HD;
    { __attribute__((address_space(3))) bf16_t* stg = (__attribute__((address_space(3))) bf16_t*)(shm + LOST) + wid * 2048;
#pragma unroll
        for (int r = 0; r < 16; ++r) { const int orow = (r & 3) + 8 * (r >> 2) + 4 * hi;
#pragma unroll
            for (int d0 = 0; d0 < 2; ++d0) stg[orow * 64 + d0 * 32 + r32] = (bf16_t)(cvtpk(o[d0][r], 0.f) & 0xffffu); }
        asm volatile("s_waitcnt lgkmcnt(0)" ::: "memory");
#pragma unroll
        for (int i = 0; i < 4; ++i) { const int row = i * 8 + (lane >> 3), ch = lane & 7; const u32x4 v = *(const __attribute__((address_space(3))) u32x4*)(stg + row * 64 + ch * 8); *(u32x4*)(Ow + (long)row * DM + ch * 8) = v; } }
    asm volatile("s_waitcnt lgkmcnt(0)\n\ts_barrier" ::: "memory");
#undef SBA_DMA_K
#undef SBA_DMA_V
}

__device__ __forceinline__ void fill_slots(const float* kbase, const float* vbase, int nvalid, lds_ptr kslot, lds_ptr vslot, int lane) {
    const int k4 = lane & 3, m = lane >> 2;
    typedef float f32x4 __attribute__((ext_vector_type(4)));
    typedef unsigned u32x2 __attribute__((ext_vector_type(2)));
    const int kofs = (m >> 1) * 1024 + (m & 1) * 8, vofs = (m >> 3) * 4096 + (m & 7) * 8;
    f32x4 kr[16], va[8];
#pragma unroll
    for (int j = 0; j < 16; ++j) { const int key = 4 * j + k4; const bool ok = key < nvalid; kr[j] = *(const f32x4*)(kbase + (size_t)(ok ? key : 0) * 512 + 4 * m); if (!ok) kr[j] = (f32x4){0.f, 0.f, 0.f, 0.f}; }
#pragma unroll
    for (int j = 0; j < 8; ++j) { const int key = 4 * j + k4; const bool ok = key < nvalid; va[j] = *(const f32x4*)(vbase + (size_t)(ok ? key : 0) * 512 + 4 * m); if (!ok) va[j] = (f32x4){0.f, 0.f, 0.f, 0.f}; }
    __builtin_amdgcn_sched_barrier(0);
#pragma unroll
    for (int j = 0; j < 16; ++j) { const int key = 4 * j + k4; *(__attribute__((address_space(3))) u32x2*)(kslot + kofs + key * 16) = (u32x2){cvtpk(kr[j][0], kr[j][1]), cvtpk(kr[j][2], kr[j][3])}; }
    __builtin_amdgcn_sched_barrier(0);
    f32x4 vb2[8];
#pragma unroll
    for (int j = 0; j < 8; ++j) { const int key = 4 * (j + 8) + k4; const bool ok = key < nvalid; vb2[j] = *(const f32x4*)(vbase + (size_t)(ok ? key : 0) * 512 + 4 * m); if (!ok) vb2[j] = (f32x4){0.f, 0.f, 0.f, 0.f}; }
    __builtin_amdgcn_sched_barrier(0);
#pragma unroll
    for (int j = 0; j < 8; ++j) { const int key = 4 * j + k4; *(__attribute__((address_space(3))) u32x2*)(vslot + vofs + (key >> 4) * 1024 + (key & 15) * 64) = (u32x2){cvtpk(va[j][0], va[j][1]), cvtpk(va[j][2], va[j][3])}; }
#pragma unroll
    for (int j = 0; j < 8; ++j) { const int key = 4 * (j + 8) + k4; *(__attribute__((address_space(3))) u32x2*)(vslot + vofs + (key >> 4) * 1024 + (key & 15) * 64) = (u32x2){cvtpk(vb2[j][0], vb2[j][1]), cvtpk(vb2[j][2], vb2[j][3])}; }
    asm volatile("s_waitcnt lgkmcnt(0)" ::: "memory");
}
__device__ __forceinline__ void sample_unit(int b, int hg, const bf16_t* Q, const float* cache_k, const float* cache_v, const int* ptab, const float* new_k, const float* new_v, const float* sb_bias, bf16_t* O, lds_ptr shm) {
    const int tid = threadIdx.x, lane = tid & 63, r32 = lane & 31, hi = lane >> 5; const int w = __builtin_amdgcn_readfirstlane(tid >> 6);
    const int h = hg * 4 + (w & 3), half = w >> 2, row0 = NP + b * ST;
    const lds_ptr kslot = shm + w * 16384, vslot = kslot + 8192;
    const lds_cptr kp = (lds_cptr)kslot + hi * 1024 + r32 * 16;
    const int vb = (int)(unsigned)(uintptr_t)vslot + ((lane >> 4) & 1) * 32 + (lane & 3) * 8 + (4 * hi + ((lane & 15) >> 2)) * 64;
    bf16x8 qr[4];
#pragma unroll
    for (int d0 = 0; d0 < 4; ++d0) { qr[d0] = (bf16x8){0, 0, 0, 0, 0, 0, 0, 0}; if (r32 < ST) qr[d0] = *reinterpret_cast<const bf16x8*>(&Q[(size_t)(row0 + r32) * DM + h * HD + d0 * 16 + hi * 8]); }
    f32x16 o[2]; o[0] = f32x16{}; o[1] = f32x16{};
    f32x16 cin; const float bias2 = sb_bias[h] * LOG2E;
#pragma unroll
    for (int r = 0; r < 16; ++r) cin[r] = bias2;
    float C = 1.0f;
    if (half == 1) { fill_slots(new_k + h * HD, new_v + h * HD, ST, kslot, vslot, lane); tile_compute<true>(kp, vb, qr, cin, o, C, hi, 0, r32); }
#pragma unroll 1
    for (int tt = 15; tt >= 0; --tt) {
        const int pos0 = 1024 * half + 64 * tt; const int page = __builtin_amdgcn_readfirstlane(ptab[b * NPAGES + (pos0 >> 7)]);
        const size_t base = ((size_t)page * PAGE + (pos0 & 127)) * 512 + h * HD;
        fill_slots(cache_k + base, cache_v + base, 64, kslot, vslot, lane);
        tile_compute<false>(kp, vb, qr, cin, o, C, hi, 0, r32);
    }
    __attribute__((address_space(3))) float* park = (__attribute__((address_space(3))) float*)(shm + (w & 3) * 16384);
    __attribute__((address_space(3))) float* cpark = (__attribute__((address_space(3))) float*)(shm + (w & 3) * 16384 + 4096);
    if (half == 0) {
#pragma unroll
        for (int r = 0; r < 4; ++r)
#pragma unroll
            for (int d0 = 0; d0 < 2; ++d0) park[(4 * hi + r) * 64 + d0 * 32 + r32] = o[d0][r]; }
    asm volatile("s_waitcnt lgkmcnt(0)\n\ts_barrier" ::: "memory");
    if (half == 1) {
        if (hi == 0 && r32 < ST) cpark[r32] = C;
        asm volatile("s_waitcnt lgkmcnt(0)" ::: "memory");
#pragma unroll
        for (int r = 0; r < 4; ++r) { const int q = 4 * hi + r; const float cq = cpark[q];
#pragma unroll
            for (int d0 = 0; d0 < 2; ++d0) { const float v = o[d0][r] + cq * park[q * 64 + d0 * 32 + r32]; O[(size_t)(row0 + q) * DM + h * HD + d0 * 32 + r32] = (bf16_t)(cvtpk(v, 0.f) & 0xffffu); } } }
    asm volatile("s_waitcnt lgkmcnt(0)\n\ts_barrier" ::: "memory");
}

__device__ __forceinline__ void sample_job(int b, int h, const bf16_t* Q, const float* cache_k, const float* cache_v, const int* ptab, const float* new_k, const float* new_v, const float* sb_bias, bf16_t* O, lds_ptr kslot, int lane) {
    const int r32 = lane & 31, hi = lane >> 5, row0 = NP + b * ST;
    const lds_ptr vslot = kslot + 8192;
    const lds_cptr kp = (lds_cptr)kslot + hi * 1024 + r32 * 16;
    const int vb = (int)(unsigned)(uintptr_t)vslot + ((lane >> 4) & 1) * 32 + (lane & 3) * 8 + (4 * hi + ((lane & 15) >> 2)) * 64;
    bf16x8 qr[4];
#pragma unroll
    for (int d0 = 0; d0 < 4; ++d0) { qr[d0] = (bf16x8){0, 0, 0, 0, 0, 0, 0, 0}; if (r32 < ST) qr[d0] = *reinterpret_cast<const bf16x8*>(&Q[(size_t)(row0 + r32) * DM + h * HD + d0 * 16 + hi * 8]); }
    f32x16 o[2]; o[0] = f32x16{}; o[1] = f32x16{};
    f32x16 cin; const float bias2 = sb_bias[h] * LOG2E;
#pragma unroll
    for (int r = 0; r < 16; ++r) cin[r] = bias2;
    float C = 1.0f;
    fill_slots(new_k + h * HD, new_v + h * HD, ST, kslot, vslot, lane); tile_compute<true>(kp, vb, qr, cin, o, C, hi, 0, r32);
#pragma unroll 1
    for (int tt = PAST / 64 - 1; tt >= 0; --tt) {
        const int pos0 = 64 * tt; const int page = __builtin_amdgcn_readfirstlane(ptab[b * NPAGES + (pos0 >> 7)]);
        const size_t base = ((size_t)page * PAGE + (pos0 & 127)) * 512 + h * HD;
        fill_slots(cache_k + base, cache_v + base, 64, kslot, vslot, lane);
        tile_compute<false>(kp, vb, qr, cin, o, C, hi, 0, r32);
    }
#pragma unroll
    for (int r = 0; r < 4; ++r) { const int q = 4 * hi + r;
#pragma unroll
        for (int d0 = 0; d0 < 2; ++d0) O[(size_t)(row0 + q) * DM + h * HD + d0 * 32 + r32] = (bf16_t)(cvtpk(o[d0][r], 0.f) & 0xffffu); }
}
#undef SBA_WAIT_BAR
}

constexpr int NWAVES = 8;
#ifndef MK_PER_PHASE
#define MK_PER_PHASE 0
#endif
constexpr int N_PHASES = 16;

constexpr size_t MiB = 1u << 20;
constexpr size_t WS_CTL = 0, CTL_ZERO_BYTES = 1 * MiB;
constexpr size_t WS_ADA_T = 2 * MiB;
constexpr size_t WS_W1IN_T = 20 * MiB;
constexpr size_t WS_W1OUT_T = 31 * MiB;
constexpr size_t WS_WIN_T = 37 * MiB;
constexpr size_t WS_GLU_T = 45 * MiB;
constexpr size_t WS_WA_T = 46 * MiB;
constexpr size_t WS_WB_T = 47 * MiB;
constexpr size_t WS_WOUT_T = 48 * MiB;
constexpr size_t WS_W2IN_T = 50 * MiB;
constexpr size_t WS_W2OUT_T = 61 * MiB;
constexpr size_t WS_SC = 67 * MiB;
constexpr size_t WS_MOD = 68 * MiB;
constexpr size_t WS_END = 73 * MiB;
constexpr size_t WS_U = 80 * MiB;
constexpr size_t WS_HID = 116 * MiB;
constexpr size_t WS_H = 212 * MiB;
constexpr size_t WS_Q = 280 * MiB;
constexpr size_t WS_KB = 298 * MiB, WS_VB = 316 * MiB;
constexpr size_t WS_S = 334 * MiB;
constexpr size_t WS_Y = 368 * MiB;
constexpr size_t WS_GA = 402 * MiB, WS_GB = 436 * MiB;
constexpr size_t WS_OA = 470 * MiB, WS_ZG = 488 * MiB, WS_OB = 506 * MiB;
constexpr size_t WS_TMP = 524 * MiB;
constexpr size_t WS_MRG = 592 * MiB;
constexpr size_t WS_KT = 628 * MiB;
constexpr size_t WS_ET = 630 * MiB;
constexpr size_t WS_FT = 638 * MiB;
constexpr size_t WS_AU = 646 * MiB;
constexpr size_t WS_AC = 662 * MiB;
constexpr size_t WS_TOTAL = 664 * MiB;
constexpr size_t WS_ZERO = 256 * 1024;
constexpr int CW_BAR = 4096;

constexpr int RING_OFF = 0, RING_BYTES = 131072;
constexpr int LDSCTL_OFF = RING_BYTES, MISC_OFF = LDSCTL_OFF + 320;
constexpr int LDS_BYTES = 147456;

#define GAS __attribute__((address_space(1)))
#define LAS __attribute__((address_space(3)))
typedef unsigned short bf16;
typedef unsigned v4u __attribute__((ext_vector_type(4)));
typedef float f32x4 __attribute__((ext_vector_type(4)));
typedef short bf16x8 __attribute__((ext_vector_type(8)));
typedef GAS unsigned gu32;
typedef GAS unsigned long long gu64;
#define RLX_AGENT __ATOMIC_RELAXED, __HIP_MEMORY_SCOPE_AGENT
#define LDS_WAIT() asm volatile("s_waitcnt lgkmcnt(0)" ::: "memory")
#define VM_WAIT() asm volatile("s_waitcnt vmcnt(0)" ::: "memory")
__device__ __forceinline__ unsigned long long rt() { return __builtin_amdgcn_s_memrealtime(); }
__device__ __forceinline__ unsigned f2bf(float f) { unsigned u = __builtin_bit_cast(unsigned, f); return (u + 0x7fffu + ((u >> 16) & 1u)) >> 16; }
__device__ __forceinline__ unsigned pk2(float lo, float hi) { return f2bf(lo) | (f2bf(hi) << 16); }

#define XB_TMO      128
#define XB_XCNT(j)  (256  + 64 * (j))
#define XB_XSUB(j)  (1280 + 64 * (j))
#define XB_XGEN(j)  (2304 + 64 * (j))
#define XB_TOP      3328
#define XB_TOPGEN   3392
#define XCD_BAR_WORDS 3456
#define XB_SPIN_CAP (1u << 18)

__device__ __forceinline__ unsigned xb_ld(unsigned* p)              { return __hip_atomic_load(p, __ATOMIC_RELAXED, __HIP_MEMORY_SCOPE_AGENT); }
__device__ __forceinline__ unsigned xb_add(unsigned* p, unsigned v) { return __hip_atomic_fetch_add(p, v, __ATOMIC_RELAXED, __HIP_MEMORY_SCOPE_AGENT); }
__device__ __forceinline__ unsigned xb_xcc_id() { return (unsigned)__builtin_amdgcn_s_getreg((3 << 11) | 20) & 0xFu; }
#define XB_SPIN(cond, bar) do { unsigned _sp = 0; while (cond) { __builtin_amdgcn_s_sleep(1); \
    if ((++_sp & 255u) == 0u) { if (xb_ld(&(bar)[XB_TMO])) break; if (_sp > XB_SPIN_CAP) { atomicAdd(&(bar)[XB_TMO], 1u); break; } } } } while (0)

struct XcdBarrier {
    unsigned* bar; unsigned x;
    volatile LAS unsigned* st;
};

__device__ __forceinline__ XcdBarrier xcd_barrier_post(unsigned* bar, volatile LAS unsigned* st) {
    XcdBarrier b; b.bar = bar; b.x = xb_xcc_id(); b.st = st;
    if (threadIdx.x == 0) (void)xb_add(&bar[XB_XCNT(b.x)], 1u);
    return b;
}
__device__ __forceinline__ void xcd_barrier_complete(unsigned* bar, unsigned x, unsigned& nloc, unsigned& nx) {
    const unsigned G = gridDim.x * gridDim.y * gridDim.z;
    unsigned sum, cnt, mine, sp = 0u;
    for (;;) {
        sum = 0u; cnt = 0u; mine = 0u;
#pragma unroll
        for (unsigned j = 0; j < 16; ++j) { const unsigned c = xb_ld(&bar[XB_XCNT(j)]); sum += c; cnt += (c > 0u) ? 1u : 0u; mine = (j == x) ? c : mine; }
        if (sum == G) break;
        __builtin_amdgcn_s_sleep(1);
        if ((++sp & 255u) == 0u) { if (xb_ld(&bar[XB_TMO])) break; if (sp > XB_SPIN_CAP) { atomicAdd(&bar[XB_TMO], 1u); break; } }
    }
    nloc = mine > 0u ? mine : 1u; nx = cnt > 0u ? cnt : 1u;
}

__device__ __forceinline__ void xcd_barrier(const XcdBarrier& b) {
    asm volatile("s_waitcnt vmcnt(0)" ::: "memory");
    __syncthreads();
    if (threadIdx.x == 0) {
        unsigned* bar = b.bar;
        __builtin_amdgcn_s_waitcnt(0);
        unsigned nloc = b.st[0], nx = b.st[1];
        if (nloc == 0u) { xcd_barrier_complete(bar, b.x, nloc, nx); b.st[0] = nloc; b.st[1] = nx; }
        const unsigned old = xb_add(&bar[XB_XSUB(b.x)], 1u);
        const unsigned gen = old / nloc;
        if (old + 1u == (gen + 1u) * nloc) {
            __builtin_amdgcn_fence(__ATOMIC_RELEASE, "agent");
            asm volatile("s_waitcnt vmcnt(0)" ::: "memory");
            const unsigned og = xb_add(&bar[XB_TOP], 1u);
            const unsigned tg = og / nx;
            if (og + 1u == (tg + 1u) * nx) xb_add(&bar[XB_TOPGEN], 1u);
            else XB_SPIN(xb_ld(&bar[XB_TOPGEN]) == tg, bar);
            __builtin_amdgcn_fence(__ATOMIC_ACQUIRE, "agent");
            xb_add(&bar[XB_XGEN(b.x)], 1u);
            asm volatile("s_waitcnt vmcnt(0)" ::: "memory");
        } else {
            XB_SPIN(xb_ld(&bar[XB_XGEN(b.x)]) == gen, bar);
            __builtin_amdgcn_fence(__ATOMIC_ACQUIRE, "agent");
            asm volatile("s_waitcnt vmcnt(0)" ::: "memory");
        }
    }
    __syncthreads();
}

struct Frame {
    LAS unsigned char* lds;
    volatile LAS unsigned* MISC;
    gu32* ctl;
    int tid, lane, wave;
    int vcu, G;
    float* out; unsigned char* ws;
};
__device__ __forceinline__ float wave_sum(float v) {
#pragma unroll
    for (int o = 1; o < 64; o <<= 1) v += __shfl_xor(v, o);
    return v;
}
__device__ __forceinline__ float sigm_f(float x) { return __builtin_amdgcn_rcpf(1.0f + __builtin_amdgcn_exp2f(-x * LOG2E)); }
__device__ __forceinline__ float gelu_tanh(float x) { return x * sigm_f(1.5957691216057308f * (x + 0.044715f * x * x * x)); }
__device__ __forceinline__ unsigned short bf1(float f) { return (unsigned short)f2bf(f); }

__device__ __forceinline__ void transpose_item(const float* W, int K, int N, bf16* WT, int k0, int n0, int dst_row0, LAS float* scr, int lane) {
#pragma unroll 8
    for (int i = 0; i < 32; ++i) { const int kk = 2 * i + (lane >> 5); scr[kk * 33 + (lane & 31)] = W[(size_t)(k0 + kk) * N + n0 + (lane & 31)]; }
    LDS_WAIT(); asm volatile("" ::: "memory");
    const int c = lane & 7;
#pragma unroll
    for (int j = 0; j < 4; ++j) { const int n = (lane >> 3) + 8 * j; const LAS float* s = scr + (8 * c) * 33 + n;
        v4u o; o.x = pk2(s[0 * 33], s[1 * 33]); o.y = pk2(s[2 * 33], s[3 * 33]); o.z = pk2(s[4 * 33], s[5 * 33]); o.w = pk2(s[6 * 33], s[7 * 33]);
        *(GAS v4u*)(WT + (size_t)(dst_row0 + n) * K + k0 + 8 * c) = o; }
    LDS_WAIT(); asm volatile("" ::: "memory");
}
__device__ __forceinline__ void transpose_plain(const float* W, int K, int N, bf16* WT, int item, LAS float* scr, int lane) {
    const int nblk = N / 32, kb = item / nblk, nb = item % nblk; transpose_item(W, K, N, WT, 64 * kb, 32 * nb, 32 * nb, scr, lane);
}
__device__ __forceinline__ void transpose_swiglu(const float* W, bf16* WT, int item, LAS float* scr, int lane) {
    const int N = 2 * FF, nblk = N / 32, kb = item / nblk, nb = item % nblk, n0 = 32 * nb; const int up = n0 >= FF ? 1 : 0, j = n0 - up * FF;
    transpose_item(W, D, N, WT, 64 * kb, n0, 256 * (j / 128) + 128 * up + (j % 128), scr, lane);
}

__device__ __forceinline__ void rmsmod_row(const float* xrow, const float* gain, const float* shift, const float* scale, bf16* orow, int lane) {
    const GAS f32x4* xr = (const GAS f32x4*)xrow + lane;
    f32x4 v[4]; float s = 0.f;
#pragma unroll
    for (int j = 0; j < 4; ++j) { v[j] = xr[64 * j]; s += (v[j].x * v[j].x + v[j].y * v[j].y) + (v[j].z * v[j].z + v[j].w * v[j].w); }
    const float rs = 1.0f / sqrtf(wave_sum(s) * (1.f / D) + RMS_EPS);
    GAS unsigned long long* o8 = (GAS unsigned long long*)orow + lane;
#pragma unroll
    for (int j = 0; j < 4; ++j) { const int c = 4 * lane + 256 * j; const f32x4 g = *(const f32x4*)(gain + c), sc = *(const f32x4*)(scale + c), sh = *(const f32x4*)(shift + c);
        const f32x4 u = v[j] * rs * g * (sc + 1.0f) + sh;
        o8[64 * j] = (unsigned long long)pk2(u.x, u.y) | ((unsigned long long)pk2(u.z, u.w) << 32); }
}
__device__ __forceinline__ void norm_phase(Frame& F, const float* hp, const float* hs, const float* gain, int sh_off, int sc_off) {
    const int gw = F.vcu * NWAVES + F.wave, NGW = F.G * NWAVES; const float* mod = (const float*)(F.ws + WS_MOD); bf16* U = (bf16*)(F.ws + WS_U);
    for (int m = gw; m < M; m += NGW) { const float* mr = mod + (size_t)seq_of_row(m) * NMOD;
        rmsmod_row(m < NP ? hp + (size_t)m * D : hs + (size_t)(m - NP) * D, gain, mr + sh_off, mr + sc_off, U + (size_t)m * D, F.lane); }
}

template <int NK, bool ISNEW>
__device__ __forceinline__ void sattn_tile(const float* kbase, const float* vbase, int lane, float bias2, const LAS float* Qs, LAS float* Ws, float (&C)[8], float (&o)[8]) {
    const int kr = lane < NK ? lane : NK - 1;
    const f32x4* kp = (const f32x4*)(kbase + (size_t)kr * 512);
    f32x4 k[16];
#pragma unroll
    for (int i = 0; i < 16; ++i) k[i] = kp[i];
    float s[8];
#pragma unroll
    for (int q = 0; q < 8; ++q) s[q] = 0.f;
#pragma unroll
    for (int d4 = 0; d4 < 16; ++d4) {
#pragma unroll
        for (int q = 0; q < 8; ++q) { const f32x4 qv = *(const LAS f32x4*)(Qs + q * 64 + d4 * 4); s[q] += (k[d4].x * qv.x + k[d4].y * qv.y) + (k[d4].z * qv.z + k[d4].w * qv.w); }
        if (d4 & 1) __builtin_amdgcn_sched_barrier(0); }
    __builtin_amdgcn_sched_barrier(0);
    float v[NK];
#pragma unroll
    for (int kk = 0; kk < NK; ++kk) v[kk] = vbase[(size_t)kk * 512 + lane];
    __builtin_amdgcn_sched_barrier(0);
    float wq[8];
#pragma unroll
    for (int q = 0; q < 8; ++q) {
        const bool valid = ISNEW ? (lane < q) : true;
        const float z = __builtin_fminf(s[q] + bias2, 60.0f);
        const float E = valid ? __builtin_amdgcn_exp2f(z) : 0.f;
        float r = valid ? __builtin_amdgcn_rcpf(1.0f + E) : 1.0f;
#pragma unroll
        for (int off = 1; off < 64; off <<= 1) { const float y = __shfl_down(r, off); if (lane + off < 64) r *= y; }
        const float tot = __builtin_bit_cast(float, __builtin_amdgcn_readfirstlane(__builtin_bit_cast(int, r)));
        wq[q] = E * r * C[q]; C[q] *= tot;
    }
    *(LAS f32x4*)(Ws + lane * 8) = (f32x4){wq[0], wq[1], wq[2], wq[3]}; *(LAS f32x4*)(Ws + lane * 8 + 4) = (f32x4){wq[4], wq[5], wq[6], wq[7]};
    LDS_WAIT(); asm volatile("" ::: "memory");
#pragma unroll
    for (int kk = 0; kk < NK; ++kk) { const f32x4 w0 = *(const LAS f32x4*)(Ws + kk * 8), w1 = *(const LAS f32x4*)(Ws + kk * 8 + 4);
        o[0] += w0.x * v[kk]; o[1] += w0.y * v[kk]; o[2] += w0.z * v[kk]; o[3] += w0.w * v[kk]; o[4] += w1.x * v[kk]; o[5] += w1.y * v[kk]; o[6] += w1.z * v[kk]; o[7] += w1.w * v[kk];
        if ((kk & 7) == 7) __builtin_amdgcn_sched_barrier(0); }
    LDS_WAIT(); asm volatile("" ::: "memory");
}
__device__ __forceinline__ void sattn_unit(Frame& F, int b, int hg, const float* sb_bias, const float* cache_k, const float* cache_v, const int* ptab) {
    const int w = F.wave, lane = F.lane, h = hg * 4 + (w & 3), half = w >> 2;
    LAS float* Qs = (LAS float*)(F.lds + RING_OFF + w * 4096);
    LAS float* Ws = (LAS float*)(F.lds + RING_OFF + w * 4096 + 2048);
    LAS float* Oc = (LAS float*)(F.lds + RING_OFF + 32768);
    const int row0 = NP + b * ST;
    const bf16* QB = (const bf16*)(F.ws + WS_Q);
    { const int q = lane >> 3, d8 = (lane & 7) * 8; const v4u raw = *(const GAS v4u*)(QB + (size_t)(row0 + q) * HW + h * HD + d8);
      LAS float* dst = Qs + q * 64 + d8;
      *(LAS f32x4*)dst = (f32x4){__builtin_bit_cast(float, raw.x << 16), __builtin_bit_cast(float, raw.x & 0xffff0000u), __builtin_bit_cast(float, raw.y << 16), __builtin_bit_cast(float, raw.y & 0xffff0000u)};
      *(LAS f32x4*)(dst + 4) = (f32x4){__builtin_bit_cast(float, raw.z << 16), __builtin_bit_cast(float, raw.z & 0xffff0000u), __builtin_bit_cast(float, raw.w << 16), __builtin_bit_cast(float, raw.w & 0xffff0000u)}; }
    LDS_WAIT(); asm volatile("" ::: "memory");
    float C[8], o[8];
#pragma unroll
    for (int q = 0; q < 8; ++q) { C[q] = 1.0f; o[q] = 0.f; }
    const float bias2 = sb_bias[h] * LOG2E;
    if (half == 1) sattn_tile<8, true>(F.out + O_KS + (size_t)b * ST * 512 + h * HD, F.out + O_VS + (size_t)b * ST * 512 + h * HD, lane, bias2, Qs, Ws, C, o);
    for (int tt = 15; tt >= 0; --tt) {
        const int pos0 = 1024 * half + 64 * tt; const int page = __builtin_amdgcn_readfirstlane(ptab[b * NPAGES + (pos0 >> 7)]);
        const size_t base = ((size_t)page * PAGE + (pos0 & 127)) * 512 + h * HD;
        sattn_tile<64, false>(cache_k + base, cache_v + base, lane, bias2, Qs, Ws, C, o);
    }
    if (half == 0) {
#pragma unroll
        for (int q = 0; q < 8; ++q) Oc[((w & 3) * 8 + q) * 64 + lane] = o[q]; }
    LDS_WAIT(); __syncthreads();
    if (half == 1) { bf16* OA = (bf16*)(F.ws + WS_OA);
#pragma unroll
        for (int q = 0; q < 8; ++q) { const float r = o[q] + C[q] * Oc[((w & 3) * 8 + q) * 64 + lane]; OA[(size_t)(row0 + q) * HW + h * HD + lane] = bf1(r); } }
    LDS_WAIT(); __syncthreads();
}

constexpr int SSM_WBYTES = 13312, SSM_XPITCH = 136;
struct SsmLane { float ar, ai, lr, li, dt; };
struct SsmPtrs { const float *lre, *lim, *ldt, *bre, *bim, *cre, *cim, *dsk, *s0r, *s0i; };
__device__ __forceinline__ SsmLane ssm_lane(const SsmPtrs& P, int g, int p) {
    SsmLane L; L.lr = P.lre[g * 64 + p]; L.li = P.lim[g * 64 + p]; L.dt = expf(P.ldt[g]);
    const float mag = expf(L.lr * L.dt); float sn, cs; sincosf(L.li * L.dt, &sn, &cs); L.ar = mag * cs; L.ai = mag * sn; return L;
}
__device__ __forceinline__ void ssm_cfrag(const SsmPtrs& P, int g, int lane, pg8::bf16x8 (&cf)[4]) {
    const int h = lane & 15, kq = lane >> 4;
#pragma unroll
    for (int s = 0; s < 4; ++s) { const float* src = (s < 2 ? P.cre : P.cim) + (size_t)(g * 16 + h) * 64 + 32 * (s & 1) + 8 * kq; const float sg = s < 2 ? 1.f : -1.f;
        const f32x4 a = *(const f32x4*)src * sg, b = *(const f32x4*)(src + 4) * sg;
        v4u w; w.x = pk2(a.x, a.y); w.y = pk2(a.z, a.w); w.z = pk2(b.x, b.y); w.w = pk2(b.z, b.w); cf[s] = __builtin_bit_cast(pg8::bf16x8, w); }
}
__device__ __forceinline__ pg8::f32x4 ssm_cproj(const LAS unsigned short* X, int blk, int lane, const pg8::bf16x8 (&cf)[4]) {
    pg8::f32x4 acc = (pg8::f32x4){0.f, 0.f, 0.f, 0.f};
#pragma unroll
    for (int s = 0; s < 4; ++s) { const pg8::bf16x8 a = *(const LAS pg8::bf16x8*)(X + (blk * 16 + (lane & 15)) * SSM_XPITCH + 32 * s + 8 * (lane >> 4));
        acc = __builtin_amdgcn_mfma_f32_16x16x32_bf16(a, cf[s], acc, 0, 0, 0); }
    return acc;
}
template <bool SAMPLE>
__device__ __forceinline__ void ssm_scan_unit(Frame& F, const SsmPtrs& P, int b, int g, int c) {
    const int lane = F.lane, p = lane;
    LAS float* U = (LAS float*)(F.lds + RING_OFF + F.wave * SSM_WBYTES); LAS unsigned short* X = (LAS unsigned short*)(F.lds + RING_OFF + F.wave * SSM_WBYTES + 4096);
    const SsmLane L = ssm_lane(P, g, p);
    const float den = L.lr * L.lr + L.li * L.li, nr = L.ar - 1.0f, ni = L.ai; const float zr = (nr * L.lr + ni * L.li) / den, zi = (ni * L.lr - nr * L.li) / den;
    float bbr[16], bbi[16];
    { const float* br = P.bre + (size_t)(g * 64 + p) * 16; const float* bi = P.bim + (size_t)(g * 64 + p) * 16;
#pragma unroll
      for (int q4 = 0; q4 < 4; ++q4) { const f32x4 r = *(const f32x4*)(br + 4 * q4), i = *(const f32x4*)(bi + 4 * q4);
#pragma unroll
          for (int e = 0; e < 4; ++e) { bbr[4 * q4 + e] = zr * r[e] - zi * i[e]; bbi[4 * q4 + e] = zr * i[e] + zi * r[e]; } } }
    pg8::bf16x8 cf[4]; ssm_cfrag(P, g, lane, cf);
    const float dsk = P.dsk[g * 16 + (lane & 15)];
    const int tok0 = SAMPLE ? NP + b * ST : b * SEQ + c * SSM_T; constexpr int T = SAMPLE ? ST : SSM_T;
    const float* S = (const float*)(F.ws + WS_S);
    if (lane < T) { const f32x4* src = (const f32x4*)(S + (size_t)(tok0 + lane) * HW + g * 16);
#pragma unroll
        for (int q4 = 0; q4 < 4; ++q4) *(LAS f32x4*)(U + lane * 16 + 4 * q4) = src[q4]; }
    LDS_WAIT(); asm volatile("" ::: "memory");
    float xr = 0.f, xi = 0.f;
    if (SAMPLE) { xr = P.s0r[(size_t)(b * NGRP + g) * 64 + p]; xi = P.s0i[(size_t)(b * NGRP + g) * 64 + p]; }
    float* Y = (float*)(F.ws + WS_Y); bf16* ZG = (bf16*)(F.ws + WS_ZG);
#pragma unroll 1
    for (int sub = 0; sub < (SAMPLE ? 1 : 2); ++sub) {
#pragma unroll 4
        for (int tt = 0; tt < (SAMPLE ? ST : 32); ++tt) { const int t = sub * 32 + tt;
            float bur = 0.f, bui = 0.f;
#pragma unroll
            for (int q4 = 0; q4 < 4; ++q4) { const f32x4 u = *(const LAS f32x4*)(U + t * 16 + 4 * q4);
#pragma unroll
                for (int e = 0; e < 4; ++e) { bur += bbr[4 * q4 + e] * u[e]; bui += bbi[4 * q4 + e] * u[e]; } }
            const float nxr = L.ar * xr - L.ai * xi + bur, nxi = L.ar * xi + L.ai * xr + bui; xr = nxr; xi = nxi;
            X[tt * SSM_XPITCH + p] = bf1(xr); X[tt * SSM_XPITCH + 64 + p] = bf1(xi); }
        LDS_WAIT(); asm volatile("" ::: "memory");
#pragma unroll
        for (int blk = 0; blk < (SAMPLE ? 1 : 2); ++blk) { const pg8::f32x4 acc = ssm_cproj(X, blk, lane, cf);
#pragma unroll
            for (int r = 0; r < 4; ++r) { const int t = sub * 32 + blk * 16 + 4 * (lane >> 4) + r, h = lane & 15; const float y = acc[r] + dsk * U[t * 16 + h];
                if (SAMPLE) { if (t < ST) ZG[(size_t)(tok0 + t) * HW + g * 16 + h] = bf1(gelu_tanh(y)); }
                else Y[(size_t)(tok0 + t) * HW + g * 16 + h] = y; } }
        LDS_WAIT(); asm volatile("" ::: "memory");
    }
    if (SAMPLE) { F.out[O_SRS + (size_t)(b * NGRP + g) * 64 + p] = xr; F.out[O_SIS + (size_t)(b * NGRP + g) * 64 + p] = xi; }
    else { float2* E = (float2*)(F.ws + WS_END); E[((size_t)(b * SSM_NCH + c) * NGRP + g) * 64 + p] = make_float2(xr, xi); }
}
__device__ __forceinline__ void ssm_fix_unit(Frame& F, const SsmPtrs& P, int b, int g, int c) {
    const int lane = F.lane, p = lane;
    LAS unsigned short* X = (LAS unsigned short*)(F.lds + RING_OFF + F.wave * SSM_WBYTES + 4096);
    const SsmLane L = ssm_lane(P, g, p);
    const float magT = expf(L.lr * L.dt * (float)SSM_T); float snT, csT; sincosf(L.li * L.dt * (float)SSM_T, &snT, &csT); const float tr = magT * csT, ti = magT * snT;
    const float2* E = (const float2*)(F.ws + WS_END);
    float cr = 0.f, ci = 0.f;
    {
        const float2* Eb = E + ((size_t)(b * SSM_NCH) * NGRP + g) * 64 + p; constexpr size_t ES = (size_t)NGRP * 64;
        int cc = 0;
        for (; cc + 16 <= c; cc += 16) { float2 e[16];
#pragma unroll
            for (int i = 0; i < 16; ++i) e[i] = Eb[(size_t)(cc + i) * ES];
#pragma unroll
            for (int i = 0; i < 16; ++i) { const float nr = tr * cr - ti * ci + e[i].x, ni = tr * ci + ti * cr + e[i].y; cr = nr; ci = ni; } }
        for (; cc < c; ++cc) { const float2 e = Eb[(size_t)cc * ES]; const float nr = tr * cr - ti * ci + e.x, ni = tr * ci + ti * cr + e.y; cr = nr; ci = ni; }
    }
    if (c == SSM_NCH - 1) { const float2 e = E[((size_t)(b * SSM_NCH + c) * NGRP + g) * 64 + p];
        F.out[O_SRP + (size_t)(b * NGRP + g) * 64 + p] = tr * cr - ti * ci + e.x; F.out[O_SIP + (size_t)(b * NGRP + g) * 64 + p] = tr * ci + ti * cr + e.y; }
    pg8::bf16x8 cf[4]; ssm_cfrag(P, g, lane, cf);
    const int tok0 = b * SEQ + c * SSM_T;
    const float* Y = (const float*)(F.ws + WS_Y); bf16* ZG = (bf16*)(F.ws + WS_ZG);
    float zr = cr, zi = ci;
#pragma unroll 1
    for (int sub = 0; sub < 2; ++sub) {
        if (c > 0) {
#pragma unroll 4
            for (int tt = 0; tt < 32; ++tt) { const float nr = L.ar * zr - L.ai * zi, ni = L.ar * zi + L.ai * zr; zr = nr; zi = ni;
                X[tt * SSM_XPITCH + p] = bf1(zr); X[tt * SSM_XPITCH + 64 + p] = bf1(zi); }
            LDS_WAIT(); asm volatile("" ::: "memory");
        }
#pragma unroll
        for (int blk = 0; blk < 2; ++blk) { pg8::f32x4 acc = (pg8::f32x4){0.f, 0.f, 0.f, 0.f}; if (c > 0) acc = ssm_cproj(X, blk, lane, cf);
#pragma unroll
            for (int r = 0; r < 4; ++r) { const int t = sub * 32 + blk * 16 + 4 * (lane >> 4) + r, h = lane & 15; const size_t idx = (size_t)(tok0 + t) * HW + g * 16 + h;
                ZG[idx] = bf1(gelu_tanh(Y[idx] + acc[r])); } }
        LDS_WAIT(); asm volatile("" ::: "memory");
    }
}


constexpr int SG_PITCH = 144, SG_TILE = 64 * SG_PITCH, SG_BUF = 4 * SG_TILE;
struct SgRegs { v4u a0, a1, b0, b1; };
__device__ __forceinline__ void sg_load(SgRegs& r, const bf16* ap, const bf16* bp) { r.a0 = *(const GAS v4u*)ap; r.a1 = *(const GAS v4u*)(ap + 64); r.b0 = *(const GAS v4u*)bp; r.b1 = *(const GAS v4u*)(bp + 64); }
__device__ __forceinline__ void sg_store(const SgRegs& r, LAS unsigned char* buf, int wofs) {
    *(LAS v4u*)(buf + wofs) = r.a0; *(LAS v4u*)(buf + SG_TILE + wofs) = r.a1; *(LAS v4u*)(buf + 2 * SG_TILE + wofs) = r.b0; *(LAS v4u*)(buf + 3 * SG_TILE + wofs) = r.b1; }
__device__ __forceinline__ void sg_compute(LAS unsigned char* buf, int aofs, int bofs, pg8::f32x4 (&acc)[2]) {
#pragma unroll
    for (int t = 0; t < 2; ++t)
#pragma unroll
        for (int s2 = 0; s2 < 2; ++s2) { const pg8::bf16x8 a = *(const LAS pg8::bf16x8*)(buf + t * SG_TILE + aofs + 64 * s2), b0 = *(const LAS pg8::bf16x8*)(buf + (2 + t) * SG_TILE + bofs + 64 * s2), b1 = *(const LAS pg8::bf16x8*)(buf + (2 + t) * SG_TILE + bofs + 16 * SG_PITCH + 64 * s2);
            acc[0] = __builtin_amdgcn_mfma_f32_16x16x32_bf16(b0, a, acc[0], 0, 0, 0); acc[1] = __builtin_amdgcn_mfma_f32_16x16x32_bf16(b1, a, acc[1], 0, 0, 0); }
}
__device__ __forceinline__ void sgemm_core(LAS unsigned char* lds, const bf16* Ag  , const bf16* Bg  , int K, int tid, int wr, int wc, int fr, int fq, pg8::f32x4 (&acc)[2]) {
    const int lr = tid >> 3, lk = (tid & 7) * 8;
    const bf16* ap = Ag + (size_t)lr * K + lk; const bf16* bp = Bg + (size_t)lr * K + lk;
    const int wofs = lr * SG_PITCH + lk * 2;
    const int aofs = (16 * wr + fr) * SG_PITCH + 16 * fq, bofs = (32 * wc + fr) * SG_PITCH + 16 * fq;
    const int ns = K / 128;
    SgRegs r0, r1; sg_load(r0, ap, bp); sg_load(r1, ap + 128, bp + 128);
    sg_store(r0, lds, wofs);
    LDS_WAIT(); __syncthreads();
#pragma unroll 1
    for (int st = 0; st < ns; st += 2) {
        if (st + 2 < ns) sg_load(r0, ap + (size_t)(st + 2) * 128, bp + (size_t)(st + 2) * 128);
        sg_compute(lds, aofs, bofs, acc);
        sg_store(r1, lds + SG_BUF, wofs);
        LDS_WAIT(); __syncthreads();
        if (st + 3 < ns) sg_load(r1, ap + (size_t)(st + 3) * 128, bp + (size_t)(st + 3) * 128);
        sg_compute(lds + SG_BUF, aofs, bofs, acc);
        if (st + 2 < ns) sg_store(r0, lds, wofs);
        LDS_WAIT(); __syncthreads();
    }
}
__device__ __forceinline__ void dg_glds16(const void* gsrc, unsigned lds_dst) { unsigned keep;
    asm volatile("s_mov_b32 %0, m0\n\ts_mov_b32 m0, %2\n\ts_nop 0\n\tglobal_load_lds_dwordx4 %1, off\n\ts_mov_b32 m0, %0" : "=&s"(keep) : "v"(gsrc), "s"(lds_dst) : "memory"); }
template <int BROWS> struct DgGeom { static constexpr int A_BYTES = 8192, B_BYTES = BROWS * 128, STAGE = A_BYTES + B_BYTES, NI = 1 + BROWS / 64; };
template <int BROWS, class Src>
__device__ __forceinline__ void dgemm_core(LAS unsigned char* lds, const Src& S, int ntile, int w, int wr, int wc, int fr, int fq, pg8::f32x4 (&acc)[BROWS / 32]) {
    typedef DgGeom<BROWS> G; constexpr int NB = 4, CW = BROWS / 2;
    const unsigned lds0 = (unsigned)(uintptr_t)lds;
#define DG_ISSUE(t_) do { const int tt_ = (t_) < ntile ? (t_) : ntile - 1; const unsigned sb_ = lds0 + (unsigned)(((t_) & (NB - 1)) * G::STAGE); \
        dg_glds16(S.a(tt_), (unsigned)__builtin_amdgcn_readfirstlane(sb_ + w * 1024)); dg_glds16(S.b(tt_, 0), (unsigned)__builtin_amdgcn_readfirstlane(sb_ + G::A_BYTES + w * 1024)); \
        if (BROWS == 128) dg_glds16(S.b(tt_, 1), (unsigned)__builtin_amdgcn_readfirstlane(sb_ + G::A_BYTES + 8192 + w * 1024)); } while (0)
    DG_ISSUE(0); DG_ISSUE(1); DG_ISSUE(2);
    const int arow = 16 * wr + fr, aswz = (arow >> 1) & 7;
    int brow[BROWS / 32], bswz[BROWS / 32];
#pragma unroll
    for (int nb = 0; nb < BROWS / 32; ++nb) { brow[nb] = CW * wc + 16 * nb + fr; bswz[nb] = (brow[nb] >> 1) & 7; }
#pragma unroll 1
    for (int i = 0; i < ntile; ++i) {
        if (BROWS == 128) asm volatile("s_waitcnt vmcnt(6)\n\ts_barrier" ::: "memory"); else asm volatile("s_waitcnt vmcnt(4)\n\ts_barrier" ::: "memory");
        DG_ISSUE(i + 3);
        LAS unsigned char* sb = lds + (i & (NB - 1)) * G::STAGE;
#pragma unroll
        for (int s2 = 0; s2 < 2; ++s2) { const pg8::bf16x8 a = *(const LAS pg8::bf16x8*)(sb + arow * 128 + (((4 * s2 + fq) ^ aswz) << 4));
#pragma unroll
            for (int nb = 0; nb < BROWS / 32; ++nb) { const pg8::bf16x8 b = *(const LAS pg8::bf16x8*)(sb + G::A_BYTES + brow[nb] * 128 + (((4 * s2 + fq) ^ bswz[nb]) << 4)); acc[nb] = __builtin_amdgcn_mfma_f32_16x16x32_bf16(b, a, acc[nb], 0, 0, 0); } }
    }
    asm volatile("s_waitcnt vmcnt(0) lgkmcnt(0)\n\ts_barrier" ::: "memory");
#undef DG_ISSUE
}
struct DgLinear { const bf16* ap; const bf16* bp; size_t bhalf;
    __device__ __forceinline__ const void* a(int t) const { return ap + 64 * t; }
    __device__ __forceinline__ const void* b(int t, int half) const { return bp + 64 * t + (half ? bhalf : 0); } };
__device__ __forceinline__ DgLinear dg_linear(const bf16* Ag, int lda, const bf16* Bg, int ldb, int w, int lane) {
    const int row = 8 * w + (lane >> 3), ch = (lane & 7) ^ ((row >> 1) & 7); DgLinear L; L.ap = Ag + (size_t)row * lda + ch * 8; L.bp = Bg + (size_t)row * ldb + ch * 8; L.bhalf = (size_t)64 * ldb; return L; }
struct SEpiResid {
    const float* base; float* out; const float* mod; int goff; float scale;
    __device__ __forceinline__ void operator()(const pg8::f32x4& v, const pg8::f32x4&, int row, int col) const {
        const size_t off = (size_t)(row - NP) * D + col; const pg8::f32x4 b = *(const pg8::f32x4*)(base + off), g = *(const pg8::f32x4*)(mod + (size_t)seq_of_row(row) * NMOD + goff + col);
        *(pg8::f32x4*)(out + off) = b + (g * scale) * v; }
};
struct SEpiInproj {
    bf16* Q; float* S; bf16* GA; bf16* GB; float* dout;
    __device__ __forceinline__ void operator()(const pg8::f32x4& v, const pg8::f32x4&, int row, int col) const {
        if (col < 512) { const pg8::f32x4 a = v * QSCALE; *(unsigned long long*)(Q + (size_t)row * HW + col) = (unsigned long long)pk2(a[0], a[1]) | ((unsigned long long)pk2(a[2], a[3]) << 32); }
        else if (col < 1536) { const bool isk = col < 1024; *(pg8::f32x4*)(dout + (isk ? O_KS : O_VS) + (size_t)(row - NP) * HW + (col - (isk ? 512 : 1024))) = v; }
        else if (col < 2048) { *(pg8::f32x4*)(S + (size_t)row * HW + (col - 1536)) = v; }
        else { const bool isa = col < 3072; bf16* o = (isa ? GA : GB) + (size_t)row * D + (col - (isa ? 2048 : 3072));
            *(unsigned long long*)o = (unsigned long long)pk2(sigm_f(v[0]), sigm_f(v[1])) | ((unsigned long long)pk2(sigm_f(v[2]), sigm_f(v[3])) << 32); }
    }
};
struct SEpiBranch {
    const bf16* GA; const bf16* GB; bf16* MRG;
    __device__ __forceinline__ void operator()(const pg8::f32x4& va, const pg8::f32x4& vb, int row, int col) const {
        const size_t off = (size_t)row * D + col; const unsigned long long ga = *(const unsigned long long*)(GA + off), gb = *(const unsigned long long*)(GB + off);
        const unsigned a0 = (unsigned)ga, a1 = (unsigned)(ga >> 32), b0 = (unsigned)gb, b1 = (unsigned)(gb >> 32);
        const float m0 = pg8::bf_lo(a0) * va[0] + pg8::bf_lo(b0) * vb[0], m1 = pg8::bf_hi(a0) * va[1] + pg8::bf_hi(b0) * vb[1];
        const float m2 = pg8::bf_lo(a1) * va[2] + pg8::bf_lo(b1) * vb[2], m3 = pg8::bf_hi(a1) * va[3] + pg8::bf_hi(b1) * vb[3];
        *(unsigned long long*)(MRG + off) = (unsigned long long)pk2(m0, m1) | ((unsigned long long)pk2(m2, m3) << 32); }
};
template <class Epi, bool DUAL>
__device__ __forceinline__ void sgemm_phase(Frame& F, const bf16* A1, const bf16* B1, int K1, const bf16* A2, const bf16* B2, int K2, int N, const Epi& E) {
    const int ncol = N / 64, nunits = (NS / 64) * ncol;
    const int w = F.wave, lane = F.lane, wr = w >> 1, wc = w & 1, fr = lane & 15, fq = lane >> 4;
    for (int u = F.vcu; u < nunits; u += F.G) {
        const int rt = u % (NS / 64), ct = u / (NS / 64);
        const int rowa = NP + rt * 64 + wr * 16 + fr, colb = ct * 64 + wc * 32;
        pg8::f32x4 acc[2], acc2[2];
#pragma unroll
        for (int i = 0; i < 2; ++i) { acc[i] = (pg8::f32x4){0.f, 0.f, 0.f, 0.f}; acc2[i] = (pg8::f32x4){0.f, 0.f, 0.f, 0.f}; }
        { const DgLinear L = dg_linear(A1 + (size_t)(NP + rt * 64) * K1, K1, B1 + (size_t)(ct * 64) * K1, K1, w, lane); dgemm_core<64, DgLinear>(F.lds + RING_OFF, L, K1 / 64, w, wr, wc, fr, fq, acc); }
        if (DUAL) { const DgLinear L = dg_linear(A2 + (size_t)(NP + rt * 64) * K2, K2, B2 + (size_t)(ct * 64) * K2, K2, w, lane); dgemm_core<64, DgLinear>(F.lds + RING_OFF, L, K2 / 64, w, wr, wc, fr, fq, acc2); }
#pragma unroll
        for (int nb = 0; nb < 2; ++nb) E(acc[nb], acc2[nb], rowa, colb + 16 * nb + 4 * fq);
    }
}


struct SsmTab { bf16* KT; bf16* ET; bf16* FT; };
__device__ __forceinline__ void ssm_build_tables(Frame& F, const SsmPtrs& P, const SsmTab& T, int g, int part) {
    typedef float f2 __attribute__((ext_vector_type(2)));
    LAS f2* pw = (LAS f2*)(F.lds + RING_OFF);
    LAS f2* Bb = (LAS f2*)(F.lds + RING_OFF + 65 * 64 * 8);
    LAS f2* Cc = Bb + 64 * 16;
    const int tid = F.tid; const float dt = expf(P.ldt[g]);
    if (tid < 64) { const int p = tid; const float lr = P.lre[g * 64 + p], li = P.lim[g * 64 + p]; const float mag = expf(lr * dt); float sn, cs; sincosf(li * dt, &sn, &cs); const float ar = mag * cs, ai = mag * sn;
        float wr = 1.0f, wi = 0.0f;
        for (int tau = 0; tau < 65; ++tau) { pw[tau * 64 + p] = (f2){wr, wi}; const float nr = wr * ar - wi * ai, ni = wr * ai + wi * ar; wr = nr; wi = ni; } }
    for (int idx = tid; idx < 64 * 16; idx += NWAVES * 64) { const int p = idx >> 4, h = idx & 15; const float lr = P.lre[g * 64 + p], li = P.lim[g * 64 + p];
        const float mag = expf(lr * dt); float sn, cs; sincosf(li * dt, &sn, &cs); const float ar = mag * cs, ai = mag * sn;
        const float den = lr * lr + li * li, nr = ar - 1.0f, ni = ai, zr = (nr * lr + ni * li) / den, zi = (ni * lr - nr * li) / den;
        const float br = P.bre[(size_t)(g * 64 + p) * 16 + h], bi = P.bim[(size_t)(g * 64 + p) * 16 + h];
        Bb[idx] = (f2){zr * br - zi * bi, zr * bi + zi * br};
        Cc[h * 64 + p] = (f2){P.cre[(size_t)(g * 16 + h) * 64 + p], P.cim[(size_t)(g * 16 + h) * 64 + p]}; }
    LDS_WAIT(); __syncthreads();
    if (part < 4) {
        const int h = (tid >> 4) & 15, hp = tid & 15, tau0 = 16 * part + (tid >> 8); float s[8];
#pragma unroll
        for (int j = 0; j < 8; ++j) s[j] = 0.f;
#pragma unroll 2
        for (int p = 0; p < 64; ++p) { const f2 b = Bb[p * 16 + hp], c = Cc[h * 64 + p]; const float cbr = c.x * b.x - c.y * b.y, cbi = c.x * b.y + c.y * b.x;
#pragma unroll
            for (int j = 0; j < 8; ++j) { const f2 w = pw[(tau0 + 2 * j) * 64 + p]; s[j] += cbr * w.x - cbi * w.y; } }
#pragma unroll
        for (int j = 0; j < 8; ++j) { const int tau = tau0 + 2 * j; float v = s[j]; if (tau == 0 && h == hp) v += P.dsk[g * 16 + h];
            T.KT[(size_t)g * 16384 + (size_t)tau * 256 + h * 16 + hp] = bf1(v); }
    } else if (part < 6) {
        for (int e8 = tid; e8 < 64 * 128; e8 += NWAVES * 64) { const int n = (part - 4) * 64 + (e8 >> 7), kk0 = (e8 & 127) * 8, ri = n >> 6, p = n & 63, k = kk0 >> 4, h0 = kk0 & 15; const f2 w = pw[(63 - k) * 64 + p]; float v[8];
#pragma unroll
            for (int i = 0; i < 8; ++i) { const f2 b = Bb[p * 16 + h0 + i]; v[i] = ri ? (w.x * b.y + w.y * b.x) : (w.x * b.x - w.y * b.y); }
            v4u o; o.x = pk2(v[0], v[1]); o.y = pk2(v[2], v[3]); o.z = pk2(v[4], v[5]); o.w = pk2(v[6], v[7]);
            *(GAS v4u*)(T.ET + ((size_t)g * 128 + n) * 1024 + kk0) = o; }
    } else {
        for (int e8 = tid; e8 < 512 * 16; e8 += NWAVES * 64) { const int row = (part - 6) * 512 + (e8 >> 4), c0 = (e8 & 15) * 8, t = row >> 4, h = row & 15, ri = c0 >> 6, p0 = c0 & 63; float v[8];
#pragma unroll
            for (int i = 0; i < 8; ++i) { const f2 c = Cc[h * 64 + p0 + i], w = pw[(t + 1) * 64 + p0 + i]; v[i] = ri ? -(c.x * w.y + c.y * w.x) : (c.x * w.x - c.y * w.y); }
            v4u o; o.x = pk2(v[0], v[1]); o.y = pk2(v[2], v[3]); o.z = pk2(v[4], v[5]); o.w = pk2(v[6], v[7]);
            *(GAS v4u*)(T.FT + ((size_t)g * 1024 + row) * 128 + c0) = o; }
    }
    LDS_WAIT(); __syncthreads();
}
__device__ __forceinline__ void ssm_stage1_unit(Frame& F, const SsmPtrs& P, const SsmTab& T, const bf16* AU, bf16* AC, int g, int b) {
    const int w = F.wave, lane = F.lane, wr = w >> 1, wc = w & 1, fr = lane & 15, fq = lane >> 4;
    LAS float* XE = (LAS float*)(F.lds + RING_OFF + 65536);
    const bf16* Ag = AU + (size_t)((g * 4 + b) * 64) * 1024;
#pragma unroll 1
    for (int ct = 0; ct < 2; ++ct) {
        pg8::f32x4 acc[2];
#pragma unroll
        for (int i = 0; i < 2; ++i) acc[i] = (pg8::f32x4){0.f, 0.f, 0.f, 0.f};
        { const DgLinear L = dg_linear(Ag, 1024, T.ET + ((size_t)g * 128 + ct * 64) * 1024, 1024, w, lane); dgemm_core<64, DgLinear>(F.lds + RING_OFF, L, 16, w, wr, wc, fr, fq, acc); }
#pragma unroll
        for (int nb = 0; nb < 2; ++nb) *(LAS pg8::f32x4*)(XE + (16 * wr + fr) * 128 + ct * 64 + 32 * wc + 16 * nb + 4 * fq) = acc[nb];
    }
    LDS_WAIT(); __syncthreads();
    if (w == 0) { const int p = lane; const float lr = P.lre[g * 64 + p], li = P.lim[g * 64 + p], dt = expf(P.ldt[g]);
        const float magT = expf(lr * dt * (float)SSM_T); float snT, csT; sincosf(li * dt * (float)SSM_T, &snT, &csT); const float tr = magT * csT, ti = magT * snT;
        float cr = 0.f, ci = 0.f; bf16* ac = AC + (size_t)((g * 4 + b) * 64) * 128;
#pragma unroll 4
        for (int c = 0; c < SSM_NCH; ++c) { ac[c * 128 + p] = bf1(cr); ac[c * 128 + 64 + p] = bf1(ci);
            const float xr = XE[c * 128 + p], xi = XE[c * 128 + 64 + p]; const float nr = tr * cr - ti * ci + xr, ni = tr * ci + ti * cr + xi; cr = nr; ci = ni; }
        F.out[O_SRP + (size_t)(b * NGRP + g) * 64 + p] = cr; F.out[O_SIP + (size_t)(b * NGRP + g) * 64 + p] = ci; }
    LDS_WAIT(); __syncthreads();
}
struct S2Src {
    const bf16* au; const bf16* ac; const bf16* kt0; const bf16* kt1; const bf16* ft0; const bf16* ft1; const bf16* zero; int nu, t0, kq;
    __device__ __forceinline__ const void* a(int t) const { return t < nu ? au + 64 * t : ac + 64 * (t - nu); }
    __device__ __forceinline__ const void* b(int t, int half) const {
        if (t < nu) { const int lag = t0 + 4 * half - (4 * t + kq); return lag >= 0 ? (half ? kt1 : kt0) + lag * 256 : zero; }
        return (half ? ft1 : ft0) + 64 * (t - nu); }
};
__device__ __forceinline__ void ssm_stage2_unit(Frame& F, const SsmTab& T, const bf16* AU, const bf16* AC, bf16* ZG, int g, int b, int j2) {
    const int w = F.wave, lane = F.lane, wr = w >> 1, wc = w & 1, fr = lane & 15, fq = lane >> 4;
    const int row = 8 * w + (lane >> 3), ch = (lane & 7) ^ ((row >> 1) & 7);
    S2Src S; S.nu = 2 * j2 + 2; S.t0 = 8 * j2 + (row >> 4); S.kq = ch >> 1; S.zero = (const bf16*)(F.ws + WS_ZERO);
    S.au = AU + ((size_t)((g * 4 + b) * 64) + row) * 1024 + ch * 8; S.ac = AC + ((size_t)((g * 4 + b) * 64) + row) * 128 + ch * 8;
    S.kt0 = T.KT + (size_t)g * 16384 + (row & 15) * 16 + (ch & 1) * 8; S.kt1 = S.kt0;
    S.ft0 = T.FT + ((size_t)g * 1024 + (size_t)S.t0 * 16 + (row & 15)) * 128 + ch * 8; S.ft1 = S.ft0 + (size_t)4 * 16 * 128;
    pg8::f32x4 acc[4];
#pragma unroll
    for (int i = 0; i < 4; ++i) acc[i] = (pg8::f32x4){0.f, 0.f, 0.f, 0.f};
    dgemm_core<128, S2Src>(F.lds + RING_OFF, S, S.nu + 2, w, wr, wc, fr, fq, acc);
    const int c = 16 * wr + fr;
#pragma unroll
    for (int nb = 0; nb < 4; ++nb) { const int col = 64 * wc + 16 * nb + 4 * fq, tt = col >> 4, h = col & 15; const size_t tok = (size_t)b * SEQ + c * SSM_T + 8 * j2 + tt;
        *(unsigned long long*)(ZG + tok * HW + g * 16 + h) = (unsigned long long)pk2(gelu_tanh(acc[nb][0]), gelu_tanh(acc[nb][1])) | ((unsigned long long)pk2(gelu_tanh(acc[nb][2]), gelu_tanh(acc[nb][3])) << 32); }
}

struct Args { const float* in[34]; float* out; unsigned char* ws; int ph_lo, ph_hi, sub, pad; };
__global__ void __launch_bounds__(NWAVES * 64, 2) sbs5_fwd(Args args) {
    extern __shared__ __attribute__((aligned(16))) unsigned char lds[];
    Frame F;
    F.lds = (LAS unsigned char*)lds;
    F.MISC = (volatile LAS unsigned*)(F.lds + MISC_OFF);
    F.tid = threadIdx.x; F.lane = F.tid & 63; F.wave = __builtin_amdgcn_readfirstlane(F.tid >> 6);
    F.G = gridDim.x; { const int bx = blockIdx.x; F.vcu = (F.G % 8 == 0) ? (bx % 8) * (F.G / 8) + bx / 8 : bx; }
    F.ws = args.ws; F.out = args.out; F.ctl = (gu32*)(args.ws + WS_CTL);
    for (int u = F.tid; u < (LDS_BYTES - LDSCTL_OFF) / 4; u += NWAVES * 64) ((LAS unsigned*)(F.lds + LDSCTL_OFF))[u] = 0u;
    __syncthreads();
    XcdBarrier bar; bar.bar = (unsigned*)(F.ctl + CW_BAR); bar.x = 0; bar.st = nullptr;
    if (!MK_PER_PHASE) bar = xcd_barrier_post((unsigned*)(F.ctl + CW_BAR), F.MISC + 8);
    const int lo = args.ph_lo, hi = args.ph_hi;
#ifndef PH_MASK
#define PH_MASK 0xFFFF
#endif
#ifndef REP_MASK
#define REP_MASK 0x10000
#endif
#define REPEAT(bit) for (int rep_ = 0; rep_ < ((((REP_MASK) >> (bit)) & 1) + 1); ++rep_)
#define IN(k) ((((PH_MASK) >> (k)) & 1) && lo <= (k) && (k) < hi)
#define SEAM(k) do { if (IN(k) && IN((k) + 1)) xcd_barrier(bar); } while (0)
    unsigned char* ws = F.ws;
    const float* MOD = (const float*)(ws + WS_MOD);
    bf16* U = (bf16*)(ws + WS_U); bf16* HID = (bf16*)(ws + WS_HID); float* H = (float*)(ws + WS_H);
    const int gw = F.vcu * NWAVES + F.wave, NGW = F.G * NWAVES;
    const SsmTab ST_{(bf16*)(args.ws + WS_KT), (bf16*)(args.ws + WS_ET), (bf16*)(args.ws + WS_FT)};
    const SsmPtrs SP{args.in[17], args.in[18], args.in[19], args.in[20], args.in[21], args.in[22], args.in[23], args.in[24], args.in[6], args.in[7]};

    if (IN(0)) REPEAT(0) {
        LAS float* scr = (LAS float*)(F.lds + RING_OFF + F.wave * 16384);
        for (int it = gw; it < (D / 64) * (NMOD / 32); it += NGW) transpose_plain(args.in[9], D, NMOD, (bf16*)(ws + WS_ADA_T), it, scr, F.lane);
        for (int r = gw; r < 256; r += NGW) { bf16* o = (bf16*)(ws + WS_SC) + (size_t)r * D;
            const float* c = r < PB ? args.in[2] + (size_t)r * D : args.in[3] + (size_t)(r - PB) * D;
#pragma unroll
            for (int j = 0; j < 4; ++j) { const int col = 4 * F.lane + 256 * j; f32x4 v = (f32x4){0.f, 0.f, 0.f, 0.f};
                if (r < NSEQ) { v = *(const f32x4*)(c + col); v.x *= sigm_f(v.x); v.y *= sigm_f(v.y); v.z *= sigm_f(v.z); v.w *= sigm_f(v.w); }
                *(unsigned long long*)(o + col) = (unsigned long long)pk2(v.x, v.y) | ((unsigned long long)pk2(v.z, v.w) << 32); } }
    }
    SEAM(0);
    if (IN(1)) REPEAT(1) {
        constexpr int NMODWG = NMOD / 256;
        if ((int)blockIdx.x < NMODWG) {
            pg8::Gemm g{(const bf16*)(ws + WS_SC), (const bf16*)(ws + WS_ADA_T), 256, NMOD, D, nullptr, nullptr}; pg8::StaticOrder S; S.init(256, NMOD, NMODWG, (int)blockIdx.x);
            pg8::EpiMod E{(float*)(ws + WS_MOD), args.in[10]};
            pg8::gemm_phase<pg8::EpiMod, pg8::StaticOrder, true, true>(F.lds + RING_OFF, g, S, E);
        } else {
            for (int tu = (int)blockIdx.x - NMODWG; tu < NGRP * 8; tu += F.G - NMODWG) ssm_build_tables(F, SP, ST_, tu >> 3, tu & 7);
            LAS float* scr = (LAS float*)(F.lds + RING_OFF + F.wave * 16384);
            const int tw = ((int)blockIdx.x - NMODWG) * NWAVES + F.wave, NTW = (F.G - NMODWG) * NWAVES;
            constexpr int I_FIN = (D / 64) * (2 * FF / 32), I_FOUT = (FF / 64) * (D / 32), I_IN = (D / 64) * (NIN / 32), I_GLU = (HW / 64) * (HW / 32), I_BR = (HW / 64) * (D / 32), I_OUT = (D / 64) * (D / 32);
            constexpr int NITEMS = 2 * I_FIN + 2 * I_FOUT + I_IN + I_GLU + 2 * I_BR + I_OUT;
            for (int it = tw; it < NITEMS; it += NTW) {
                int r = it;
                if (r < I_FIN) { transpose_swiglu(args.in[12], (bf16*)(ws + WS_W1IN_T), r, scr, F.lane); continue; } r -= I_FIN;
                if (r < I_FOUT) { transpose_plain(args.in[13], FF, D, (bf16*)(ws + WS_W1OUT_T), r, scr, F.lane); continue; } r -= I_FOUT;
                if (r < I_IN) { transpose_plain(args.in[15], D, NIN, (bf16*)(ws + WS_WIN_T), r, scr, F.lane); continue; } r -= I_IN;
                if (r < I_GLU) { transpose_plain(args.in[25], HW, HW, (bf16*)(ws + WS_GLU_T), r, scr, F.lane); continue; } r -= I_GLU;
                if (r < I_BR) { transpose_plain(args.in[27], HW, D, (bf16*)(ws + WS_WA_T), r, scr, F.lane); continue; } r -= I_BR;
                if (r < I_BR) { transpose_plain(args.in[28], HW, D, (bf16*)(ws + WS_WB_T), r, scr, F.lane); continue; } r -= I_BR;
                if (r < I_OUT) { transpose_plain(args.in[29], D, D, (bf16*)(ws + WS_WOUT_T), r, scr, F.lane); continue; } r -= I_OUT;
                if (r < I_FIN) { transpose_swiglu(args.in[31], (bf16*)(ws + WS_W2IN_T), r, scr, F.lane); continue; } r -= I_FIN;
                transpose_plain(args.in[32], FF, D, (bf16*)(ws + WS_W2OUT_T), r, scr, F.lane);
            }
        }
    }
    SEAM(1);
    if (IN(2)) REPEAT(2) norm_phase(F, args.in[0], args.in[1], args.in[11], MOD_SH1, MOD_SC1);
    SEAM(2);
    if (IN(3)) REPEAT(3) { pg8::Gemm g{U, (const bf16*)(ws + WS_W1IN_T), M, 2 * FF, D, nullptr, nullptr}; pg8::StaticOrder S; S.init(M, 2 * FF, F.G, (int)blockIdx.x);
        pg8::EpiSwiglu E{HID}; pg8::gemm_phase<pg8::EpiSwiglu, pg8::StaticOrder, true, true>(F.lds + RING_OFF, g, S, E); }
    SEAM(3);
    if (IN(4)) { pg8::Gemm g{HID, (const bf16*)(ws + WS_W1OUT_T), NP, D, FF, nullptr, nullptr}; pg8::StaticOrder S; S.init(NP, D, F.G, (int)blockIdx.x);
        pg8::EpiResid E{args.in[0], args.in[1], H, MOD, MOD_G1, 0.5f}; REPEAT(4) pg8::gemm_phase<pg8::EpiResid, pg8::StaticOrder, true, true>(F.lds + RING_OFF, g, S, E);
        SEpiResid SE{args.in[1], H + (size_t)NP * D, MOD, MOD_G1, 0.5f}; REPEAT(16) sgemm_phase<SEpiResid, false>(F, HID, (const bf16*)(ws + WS_W1OUT_T), FF, nullptr, nullptr, 0, D, SE); }
    SEAM(4);
    if (IN(5)) REPEAT(5) norm_phase(F, H, H + (size_t)NP * D, args.in[14], MOD_SH2, MOD_SC2);
    SEAM(5);
    if (IN(6)) { pg8::Gemm g{U, (const bf16*)(ws + WS_WIN_T), NP, NIN, D, nullptr, nullptr}; pg8::StaticOrder S; S.init(NP, NIN, F.G, (int)blockIdx.x);
        pg8::EpiInproj E{(bf16*)(ws + WS_Q), (bf16*)(ws + WS_KB), (bf16*)(ws + WS_VB), (bf16*)(ws + WS_AU), (bf16*)(ws + WS_GA), (bf16*)(ws + WS_GB), F.out};
        REPEAT(6) pg8::gemm_phase<pg8::EpiInproj, pg8::StaticOrder, true, true>(F.lds + RING_OFF, g, S, E);
        SEpiInproj SE{(bf16*)(ws + WS_Q), (float*)(ws + WS_S), (bf16*)(ws + WS_GA), (bf16*)(ws + WS_GB), F.out}; REPEAT(17) sgemm_phase<SEpiInproj, false>(F, U, (const bf16*)(ws + WS_WIN_T), D, nullptr, nullptr, 0, NIN, SE); }
    SEAM(6);
    if (IN(7)) {
#ifndef P7_MASK
#define P7_MASK 7
#endif
        const int grp = F.vcu % 3;
#define P7_S() do { if (P7_MASK & 2) REPEAT(19) for (int ui = F.vcu; ui < 256; ui += F.G) sba::sample_unit(ui >> 1, ui & 1, (const bf16*)(ws + WS_Q), args.in[4], args.in[5], (const int*)args.in[8], F.out + O_KS + (size_t)(ui >> 1) * ST * 512, F.out + O_VS + (size_t)(ui >> 1) * ST * 512, args.in[16], (bf16*)(ws + WS_OA), (sba::lds_ptr)(F.lds + RING_OFF)); __syncthreads(); } while (0)
        if (grp == 0) P7_S();
        if (P7_MASK & 1) REPEAT(7) for (int pi = F.vcu; pi < 256; pi += F.G) { const int bh = pi >> 3, s = pi & 7, b = bh >> 3, h = bh & 7; const float bias2 = args.in[16][h] * LOG2E;
            sba::unit(b, h, 15 - s, (const bf16*)(ws + WS_Q), (const bf16*)(ws + WS_KB), (const bf16*)(ws + WS_VB), (bf16*)(ws + WS_OA), bias2, (sba::lds_ptr)(F.lds + RING_OFF));
            sba::unit(b, h, s, (const bf16*)(ws + WS_Q), (const bf16*)(ws + WS_KB), (const bf16*)(ws + WS_VB), (bf16*)(ws + WS_OA), bias2, (sba::lds_ptr)(F.lds + RING_OFF)); }
        __syncthreads();
        if (grp == 1) P7_S();
        if (P7_MASK & 4) REPEAT(20) { const int half = F.G >> 1;
            if (F.vcu < half) { for (int su = F.vcu; su < NGRP * PB; su += half) ssm_stage1_unit(F, SP, ST_, (const bf16*)(ws + WS_AU), (bf16*)(ws + WS_AC), su >> 2, su & 3); }
            else { for (int wu = F.vcu - half; wu < SB * 4; wu += F.G - half) ssm_scan_unit<true>(F, SP, wu >> 2, (wu & 3) * 8 + F.wave, 0); } }
        __syncthreads();
        if (grp == 2) P7_S();
#undef P7_S
    }
    SEAM(7);
    if (IN(8)) REPEAT(8) {
        for (int pu = F.vcu; pu < NGRP * PB * 4; pu += F.G) { const int gb = pu >> 2, j4 = pu & 3;
            ssm_stage2_unit(F, ST_, (const bf16*)(ws + WS_AU), (const bf16*)(ws + WS_AC), (bf16*)(ws + WS_ZG), gb >> 2, gb & 3, 7 - j4);
            ssm_stage2_unit(F, ST_, (const bf16*)(ws + WS_AU), (const bf16*)(ws + WS_AC), (bf16*)(ws + WS_ZG), gb >> 2, gb & 3, j4); } }
    SEAM(8);
    if (IN(9)) REPEAT(9) { pg8::Gemm g{(const bf16*)(ws + WS_ZG), (const bf16*)(ws + WS_GLU_T), M, HW, HW, nullptr, nullptr}; pg8::StaticOrder S; S.init(M, HW, F.G, (int)blockIdx.x);
        pg8::EpiGlu E{(const bf16*)(ws + WS_ZG), (bf16*)(ws + WS_OB), args.in[26]}; pg8::gemm_phase<pg8::EpiGlu, pg8::StaticOrder, true, true>(F.lds + RING_OFF, g, S, E); }
    SEAM(9);
    if (IN(10)) { pg8::Gemm g{(const bf16*)(ws + WS_OA), (const bf16*)(ws + WS_WA_T), NP, D, HW, (const bf16*)(ws + WS_OB), (const bf16*)(ws + WS_WB_T)};
        pg8::EpiBranch E{(const bf16*)(ws + WS_GA), (const bf16*)(ws + WS_GB), (float*)(ws + WS_TMP), (bf16*)(ws + WS_MRG)};
        pg8::PairOrder S; S.init(NP, D, F.G, (int)blockIdx.x); REPEAT(10) pg8::gemm_phase<pg8::EpiBranch, pg8::PairOrder, true, true>(F.lds + RING_OFF, g, S, E);
        SEpiBranch SE{(const bf16*)(ws + WS_GA), (const bf16*)(ws + WS_GB), (bf16*)(ws + WS_MRG)};
        REPEAT(18) sgemm_phase<SEpiBranch, true>(F, (const bf16*)(ws + WS_OA), (const bf16*)(ws + WS_WA_T), HW, (const bf16*)(ws + WS_OB), (const bf16*)(ws + WS_WB_T), HW, D, SE); }
    SEAM(10);
    if (IN(11)) { pg8::Gemm g{(const bf16*)(ws + WS_MRG), (const bf16*)(ws + WS_WOUT_T), NP, D, D, nullptr, nullptr}; pg8::StaticOrder S; S.init(NP, D, F.G, (int)blockIdx.x);
        pg8::EpiResid E{H, H + (size_t)NP * D, H, MOD, MOD_G2, 1.0f}; pg8::gemm_phase<pg8::EpiResid, pg8::StaticOrder, true, true>(F.lds + RING_OFF, g, S, E);
        SEpiResid SE{H + (size_t)NP * D, H + (size_t)NP * D, MOD, MOD_G2, 1.0f}; sgemm_phase<SEpiResid, false>(F, (const bf16*)(ws + WS_MRG), (const bf16*)(ws + WS_WOUT_T), D, nullptr, nullptr, 0, D, SE); }
    SEAM(11);
    if (IN(12)) REPEAT(12) norm_phase(F, H, H + (size_t)NP * D, args.in[30], MOD_SH3, MOD_SC3);
    SEAM(12);
    if (IN(13)) REPEAT(13) { pg8::Gemm g{U, (const bf16*)(ws + WS_W2IN_T), M, 2 * FF, D, nullptr, nullptr}; pg8::StaticOrder S; S.init(M, 2 * FF, F.G, (int)blockIdx.x);
        pg8::EpiSwiglu E{HID}; pg8::gemm_phase<pg8::EpiSwiglu, pg8::StaticOrder, true, true>(F.lds + RING_OFF, g, S, E); }
    SEAM(13);
    if (IN(14)) { pg8::Gemm g{HID, (const bf16*)(ws + WS_W2OUT_T), NP, D, FF, nullptr, nullptr}; pg8::StaticOrder S; S.init(NP, D, F.G, (int)blockIdx.x);
        pg8::EpiResid E{H, H + (size_t)NP * D, H, MOD, MOD_G3, 0.5f}; pg8::gemm_phase<pg8::EpiResid, pg8::StaticOrder, true, true>(F.lds + RING_OFF, g, S, E);
        SEpiResid SE{H + (size_t)NP * D, H + (size_t)NP * D, MOD, MOD_G3, 0.5f}; sgemm_phase<SEpiResid, false>(F, HID, (const bf16*)(ws + WS_W2OUT_T), FF, nullptr, nullptr, 0, D, SE); }
    SEAM(14);
#ifdef DBG_DUMP
    {
        const bf16* s0 = (const bf16*)(ws + (DBG_DUMP == 1 ? WS_ZG : DBG_DUMP == 2 ? WS_MRG : DBG_DUMP == 3 ? WS_U : DBG_DUMP == 4 ? WS_OA : WS_GA));
        const bf16* s1 = (const bf16*)(ws + (DBG_DUMP == 1 ? WS_OB : DBG_DUMP == 2 ? WS_MRG + (size_t)M * 1024 : DBG_DUMP == 3 ? WS_U + (size_t)M * 1024 : DBG_DUMP == 4 ? WS_OB : WS_GA + (size_t)M * 1024));
        const size_t n = (size_t)M * 512;
        for (size_t i = (size_t)blockIdx.x * 512 + F.tid; i < n; i += (size_t)F.G * 512) { F.out[i] = __builtin_bit_cast(float, (unsigned)s0[i] << 16); F.out[n + i] = __builtin_bit_cast(float, (unsigned)s1[i] << 16); }
    }
#endif
#ifdef EXTRA_BARRIERS
    for (int xb_ = 0; xb_ < EXTRA_BARRIERS; ++xb_) xcd_barrier(bar);
#endif
    if (IN(15)) REPEAT(15) {
        for (int m = gw; m < M; m += NGW) { const GAS f32x4* xr = (const GAS f32x4*)(H + (size_t)m * D) + F.lane; f32x4 v[4]; float s = 0.f;
#pragma unroll
            for (int j = 0; j < 4; ++j) { v[j] = xr[64 * j]; s += (v[j].x * v[j].x + v[j].y * v[j].y) + (v[j].z * v[j].z + v[j].w * v[j].w); }
            const float rs = 1.0f / sqrtf(wave_sum(s) * (1.f / D) + RMS_EPS);
            float* orow = F.out + (m < NP ? O_YP + (size_t)m * D : O_YS + (size_t)(m - NP) * D);
#pragma unroll
            for (int j = 0; j < 4; ++j) { const int c = 4 * F.lane + 256 * j; *(f32x4*)(orow + c) = v[j] * rs * *(const f32x4*)(args.in[33] + c); } }
    }
#undef IN
#undef SEAM
}

extern "C" void kernel_launch(void* const* d_in, const int* in_sizes, int n_in, void* d_out, int out_size, void* d_ws, size_t ws_size, hipStream_t stream) {
    static int grid = 0;
    if (grid == 0) {
        if (n_in != 34 || out_size != (int)O_TOTAL || ws_size < WS_TOTAL) { fprintf(stderr, "kernel_launch: unexpected shapes (n_in %d, out %d, ws %zu); nothing launched\n", n_in, out_size, ws_size); grid = -1; return; }
        int dev = 0, cus = 0, per_cu = 0;
        if (hipGetDevice(&dev) != hipSuccess || hipDeviceGetAttribute(&cus, hipDeviceAttributeMultiprocessorCount, dev) != hipSuccess) { grid = -1; return; }
        if (hipFuncSetAttribute((const void*)sbs5_fwd, hipFuncAttributeMaxDynamicSharedMemorySize, LDS_BYTES) != hipSuccess) { fprintf(stderr, "kernel_launch: hipFuncSetAttribute failed\n"); grid = -1; return; }
        if (hipOccupancyMaxActiveBlocksPerMultiprocessor(&per_cu, (const void*)sbs5_fwd, NWAVES * 64, LDS_BYTES) != hipSuccess || per_cu < 1) { fprintf(stderr, "kernel_launch: occupancy query reports %d workgroups per CU\n", per_cu); }
        (void)hipGetLastError();
        grid = cus;
    }
    if (grid < 0) return;
    (void)hipMemsetAsync((char*)d_ws + WS_CTL, 0, CTL_ZERO_BYTES, stream);
    Args a{};
    for (int i = 0; i < 34; ++i) a.in[i] = (const float*)d_in[i];
    a.out = (float*)d_out; a.ws = (unsigned char*)d_ws;
#if MK_PER_PHASE
    for (int ph = 0; ph < N_PHASES; ++ph) { a.ph_lo = ph; a.ph_hi = ph + 1; a.sub = 0; hipLaunchKernelGGL(sbs5_fwd, dim3(grid), dim3(NWAVES * 64), LDS_BYTES, stream, a); }
#else
    a.ph_lo = 0; a.ph_hi = N_PHASES; a.sub = -1; hipLaunchKernelGGL(sbs5_fwd, dim3(grid), dim3(NWAVES * 64), LDS_BYTES, stream, a);
#endif
    const hipError_t le = hipPeekAtLastError();
    if (le != hipSuccess) fprintf(stderr, "kernel_launch: launch failed: %s (grid %d)\n", hipGetErrorName(le), grid);
}
```

```cpp
#include <hip/hip_runtime.h>
#include <cstdio>
#include <cstdint>

constexpr int D = 1024, NP = 16384, NS = 1024, M = NP + NS, FF = 2816, NIN = 4096, HW = 512, NSEQ = 132, NMOD = 9216;
constexpr int SEQ = 4096, PB = 4, SB = 128, ST = 8, NHEAD = 8, HD = 64, NGRP = 32, NSTATE = 64, PAST = 2048, PAGE = 128, NPAGES = 16;
constexpr int SSM_T = 64, SSM_NCH = SEQ / SSM_T;
constexpr float RMS_EPS = 1e-6f, LOG2E = 1.4426950408889634f, QSCALE = 0.125f * 1.4426950408889634f;
constexpr int MOD_SH1 = 0, MOD_SC1 = 1024, MOD_G1 = 2048, MOD_SH2 = 3072, MOD_SC2 = 4096, MOD_G2 = 5120, MOD_SH3 = 6144, MOD_SC3 = 7168, MOD_G3 = 8192;
constexpr size_t O_YP = 0, O_YS = 16777216, O_KP = 17825792, O_VP = 26214400, O_SRP = 34603008, O_SIP = 34611200, O_KS = 34619392, O_VS = 35143680, O_SRS = 35667968, O_SIS = 35930112, O_TOTAL = 36192256;
__host__ __device__ __forceinline__ int seq_of_row(int row) { return row < NP ? (row >> 12) : 4 + ((row - NP) >> 3); }
namespace pg8 {
#define PG8_LAS __attribute__((address_space(3)))
typedef unsigned short bf16_t;
typedef short bf16x8 __attribute__((ext_vector_type(8)));
typedef float f32x4 __attribute__((ext_vector_type(4)));
typedef unsigned u32x4 __attribute__((ext_vector_type(4)));
constexpr int BM = 256, BK = 64, HALF = 128, HTB = HALF * BK * 2  , STAGE_BYTES = 8 * HTB, NXCD = 8, WGM = 8;

__host__ __device__ __forceinline__ int lds_byte(int r, int c) { const int st = (r >> 4) * 2 + (c >> 5), rr = r & 15, cc = c & 31, ob = rr * 64 + cc * 2; return st * 1024 + (ob ^ (((ob >> 9) & 1) << 5)); }
__host__ __device__ __forceinline__ void stage_rc(int b, int& R, int& C) { const int st = b / 1024, sb = b % 1024, swz = sb ^ (((sb >> 9) & 1) << 5); R = (st >> 1) * 16 + swz / 64; C = (st & 1) * 32 + (swz % 64) / 2; }
__host__ __device__ __forceinline__ int perm32(int rho) { const int n = rho >> 4, i = rho & 15; return 8 * (i >> 2) + 4 * n + (i & 3); }

struct Unit { int pm, pn, sel; };
struct Gemm { const bf16_t* A; const bf16_t* Bt; int M, N, K; const bf16_t* A2; const bf16_t* Bt2; };

struct StaticOrder {
    int nM, nN, nwg, G, c;
    __host__ __device__ void init(int M, int N, int G_, int c_) { nM = M / BM; nN = N / BM; nwg = nM * nN; G = G_; c = c_; }
    __host__ __device__ bool next(int i, Unit& u) const { return at((long)i * G + c, u); }
    __host__ __device__ bool at(long L, Unit& u) const {
        if (L >= nwg) return false;
        int wgid = (int)L; { const int q = nwg / NXCD, r = nwg % NXCD, xcd = wgid % NXCD, off = wgid / NXCD; wgid = (xcd < r ? xcd * (q + 1) : r * (q + 1) + (xcd - r) * q) + off; }
        const int nig = WGM * nN, gid = wgid / nig, fm = gid * WGM, gsz = (nM - fm) < WGM ? (nM - fm) : WGM;
        u.pm = fm + ((wgid % nig) % gsz); u.pn = (wgid % nig) / gsz; u.sel = 0; return true;
    }
    __device__ __forceinline__ void a_ready(const Unit&) const {}
    __device__ __forceinline__ void done(const Unit&) const {}
};

typedef float f32x2c __attribute__((ext_vector_type(2))); typedef __bf16 bf16x2c __attribute__((ext_vector_type(2)));
__device__ __forceinline__ unsigned cvt_pk_bf16(float lo, float hi) { f32x2c v = {lo, hi}; bf16x2c b = __builtin_convertvector(v, bf16x2c); return __builtin_bit_cast(unsigned, b); }
typedef float f32x2 __attribute__((ext_vector_type(2)));
__device__ __forceinline__ float sigm(float x) { return __builtin_amdgcn_rcpf(1.0f + __builtin_amdgcn_exp2f(-x * LOG2E)); }
__device__ __forceinline__ float bf_lo(unsigned w) { return __builtin_bit_cast(float, w << 16); }
__device__ __forceinline__ float bf_hi(unsigned w) { return __builtin_bit_cast(float, w & 0xffff0000u); }

struct EpiMod {
    static constexpr bool PERM = false, AFTER_DRAIN = false;
    float* mod; const float* bias;
    __device__ __forceinline__ void operator()(const f32x4 (&acc)[2][2][4][2], const Unit& u, int wr, int wc, int fr, int fq) const {
        const int col0 = u.pn * BM + wc * 32 + 4 * fq;
#pragma unroll
        for (int ai = 0; ai < 2; ++ai)
#pragma unroll
            for (int m = 0; m < 4; ++m) { const int row = u.pm * BM + ai * HALF + wr * 64 + m * 16 + fr;
                if (row < NSEQ) {
#pragma unroll
                    for (int bj = 0; bj < 2; ++bj)
#pragma unroll
                        for (int n = 0; n < 2; ++n) { const int col = col0 + bj * HALF + n * 16;
                            *(f32x4*)(mod + (size_t)row * NMOD + col) = acc[ai][bj][m][n] + *(const f32x4*)(bias + col); } } }
    }
};

struct EpiSwiglu {
    static constexpr bool PERM = true, AFTER_DRAIN = false;
    bf16_t* H;
    __device__ __forceinline__ void operator()(const f32x4 (&acc)[2][2][4][2], const Unit& u, int wr, int wc, int fr, int fq) const {
        const int row0 = u.pm * BM + wr * 64 + fr, col0 = u.pn * HALF + wc * 32 + 8 * fq;
#pragma unroll
        for (int ai = 0; ai < 2; ++ai)
#pragma unroll
            for (int m = 0; m < 4; ++m) { bf16_t* rowp = H + (size_t)(row0 + ai * HALF + m * 16) * FF + col0;
                float o[8];
#pragma unroll
                for (int n = 0; n < 2; ++n)
#pragma unroll
                    for (int e = 0; e < 4; ++e) { const float g = acc[ai][0][m][n][e], up = acc[ai][1][m][n][e]; o[n * 4 + e] = g * sigm(g) * up; }
                u32x4 w; w.x = cvt_pk_bf16(o[0], o[1]); w.y = cvt_pk_bf16(o[2], o[3]); w.z = cvt_pk_bf16(o[4], o[5]); w.w = cvt_pk_bf16(o[6], o[7]);
                *(u32x4*)rowp = w; }
    }
};

struct EpiResid {
    static constexpr bool PERM = false, AFTER_DRAIN = false;
    const float* base_p; const float* base_s; float* out; const float* mod; int goff; float scale;
    __device__ __forceinline__ void operator()(const f32x4 (&acc)[2][2][4][2], const Unit& u, int wr, int wc, int fr, int fq) const {
        const int col0 = u.pn * BM + wc * 32 + 4 * fq;
#pragma unroll
        for (int ai = 0; ai < 2; ++ai)
#pragma unroll
            for (int m = 0; m < 4; ++m) { const int row = u.pm * BM + ai * HALF + wr * 64 + m * 16 + fr;
                const float* bp = (row < NP ? base_p + (size_t)row * D : base_s + (size_t)(row - NP) * D) + col0;
                const float* gp = mod + (size_t)seq_of_row(row) * NMOD + goff + col0; float* op = out + (size_t)row * D + col0;
#pragma unroll
                for (int bj = 0; bj < 2; ++bj)
#pragma unroll
                    for (int n = 0; n < 2; ++n) { const int c = bj * HALF + n * 16;
                        const f32x4 b = *(const f32x4*)(bp + c), g = *(const f32x4*)(gp + c);
                        *(f32x4*)(op + c) = b + (g * scale) * acc[ai][bj][m][n]; } }
    }
};

struct EpiInproj {
    static constexpr bool PERM = true, AFTER_DRAIN = false;
    bf16_t* Q; bf16_t* KB; bf16_t* VB; bf16_t* AU; bf16_t* GA; bf16_t* GB; float* dout;
    __device__ __forceinline__ void operator()(const f32x4 (&acc)[2][2][4][2], const Unit& u, int wr, int wc, int fr, int fq) const {
        const int row0 = u.pm * BM + wr * 64 + fr, ct = wc * 32 + 8 * fq, pn = u.pn;
#pragma unroll
        for (int ai = 0; ai < 2; ++ai)
#pragma unroll
            for (int m = 0; m < 4; ++m) { const int row = row0 + ai * HALF + m * 16;
#pragma unroll
                for (int bj = 0; bj < 2; ++bj) { const f32x4 v0 = acc[ai][bj][m][0], v1 = acc[ai][bj][m][1];
                    if (pn < 2) { const int col = pn * BM + bj * HALF + ct; const f32x4 a = v0 * QSCALE, b = v1 * QSCALE;
                        u32x4 w; w.x = cvt_pk_bf16(a[0], a[1]); w.y = cvt_pk_bf16(a[2], a[3]); w.z = cvt_pk_bf16(b[0], b[1]); w.w = cvt_pk_bf16(b[2], b[3]);
                        *(u32x4*)(Q + (size_t)row * HW + col) = w;
                    } else if (pn < 6) { const bool isk = pn < 4; const int col = (pn - (isk ? 2 : 4)) * BM + bj * HALF + ct;
                        float* fo = dout + (row < NP ? (isk ? O_KP : O_VP) + (size_t)row * HW : (isk ? O_KS : O_VS) + (size_t)(row - NP) * HW) + col;
                        *(f32x4*)fo = v0; *(f32x4*)(fo + 4) = v1;
                        u32x4 w; w.x = cvt_pk_bf16(v0[0], v0[1]); w.y = cvt_pk_bf16(v0[2], v0[3]); w.z = cvt_pk_bf16(v1[0], v1[1]); w.w = cvt_pk_bf16(v1[2], v1[3]);
                        *(u32x4*)((isk ? KB : VB) + (size_t)row * HW + col) = w;
                    } else if (pn < 8) { const int col = (pn - 6) * BM + bj * HALF + ct;
                        const int g = col >> 4, bb = row >> 12, cch = (row >> 6) & 63, tt = row & 63;
                        u32x4 w; w.x = cvt_pk_bf16(v0[0], v0[1]); w.y = cvt_pk_bf16(v0[2], v0[3]); w.z = cvt_pk_bf16(v1[0], v1[1]); w.w = cvt_pk_bf16(v1[2], v1[3]);
                        *(u32x4*)(AU + ((size_t)((g * 4 + bb) * 64 + cch)) * 1024 + tt * 16 + (col & 15)) = w;
                    } else { const bool isa = pn < 12; const int col = (pn - (isa ? 8 : 12)) * BM + bj * HALF + ct;
                        u32x4 w; w.x = cvt_pk_bf16(sigm(v0[0]), sigm(v0[1])); w.y = cvt_pk_bf16(sigm(v0[2]), sigm(v0[3])); w.z = cvt_pk_bf16(sigm(v1[0]), sigm(v1[1])); w.w = cvt_pk_bf16(sigm(v1[2]), sigm(v1[3]));
                        *(u32x4*)((isa ? GA : GB) + (size_t)row * D + col) = w; } } }
    }
};

struct EpiGlu {
    static constexpr bool PERM = true, AFTER_DRAIN = false;
    const bf16_t* ZG; bf16_t* OB; const float* bias;
    __device__ __forceinline__ void operator()(const f32x4 (&acc)[2][2][4][2], const Unit& u, int wr, int wc, int fr, int fq) const {
        const int row0 = u.pm * BM + wr * 64 + fr, col0 = u.pn * BM + wc * 32 + 8 * fq;
#pragma unroll
        for (int ai = 0; ai < 2; ++ai)
#pragma unroll
            for (int m = 0; m < 4; ++m) { const int row = row0 + ai * HALF + m * 16;
#pragma unroll
                for (int bj = 0; bj < 2; ++bj) { const int col = col0 + bj * HALF;
                    const f32x4 v0 = acc[ai][bj][m][0] + *(const f32x4*)(bias + col), v1 = acc[ai][bj][m][1] + *(const f32x4*)(bias + col + 4);
                    const u32x4 z = *(const u32x4*)(ZG + (size_t)row * HW + col);
                    u32x4 w; w.x = cvt_pk_bf16(bf_lo(z.x) * sigm(v0[0]), bf_hi(z.x) * sigm(v0[1])); w.y = cvt_pk_bf16(bf_lo(z.y) * sigm(v0[2]), bf_hi(z.y) * sigm(v0[3]));
                    w.z = cvt_pk_bf16(bf_lo(z.z) * sigm(v1[0]), bf_hi(z.z) * sigm(v1[1])); w.w = cvt_pk_bf16(bf_lo(z.w) * sigm(v1[2]), bf_hi(z.w) * sigm(v1[3]));
                    *(u32x4*)(OB + (size_t)row * HW + col) = w; } }
    }
};

struct EpiBranch {
    static constexpr bool PERM = true, AFTER_DRAIN = false;
    const bf16_t* GA; const bf16_t* GB; float* TMP; bf16_t* MRG;
    __device__ __forceinline__ void operator()(const f32x4 (&acc)[2][2][4][2], const Unit& u, int wr, int wc, int fr, int fq) const { pass(acc, u, wr, wc, fr, fq, u.sel != 0); }
    __device__ __forceinline__ void pass(const f32x4 (&acc)[2][2][4][2], const Unit& u, int wr, int wc, int fr, int fq, const bool second) const {
        const int row0 = u.pm * BM + wr * 64 + fr, col0 = u.pn * BM + wc * 32 + 8 * fq;
#pragma unroll
        for (int ai = 0; ai < 2; ++ai)
#pragma unroll
            for (int m = 0; m < 4; ++m) { const int row = row0 + ai * HALF + m * 16;
#pragma unroll
                for (int bj = 0; bj < 2; ++bj) { const int col = col0 + bj * HALF; const size_t off = (size_t)row * D + col;
                    const u32x4 gz = *(const u32x4*)((second ? GB : GA) + off);
                    f32x4 g0 = (f32x4){bf_lo(gz.x), bf_hi(gz.x), bf_lo(gz.y), bf_hi(gz.y)}, g1 = (f32x4){bf_lo(gz.z), bf_hi(gz.z), bf_lo(gz.w), bf_hi(gz.w)};
                    f32x4 t0 = g0 * acc[ai][bj][m][0], t1 = g1 * acc[ai][bj][m][1];
                    if (!second) { *(f32x4*)(TMP + off) = t0; *(f32x4*)(TMP + off + 4) = t1; }
                    else { t0 += *(const f32x4*)(TMP + off); t1 += *(const f32x4*)(TMP + off + 4);
                        u32x4 w; w.x = cvt_pk_bf16(t0[0], t0[1]); w.y = cvt_pk_bf16(t0[2], t0[3]); w.z = cvt_pk_bf16(t1[0], t1[1]); w.w = cvt_pk_bf16(t1[2], t1[3]);
                        *(u32x4*)(MRG + off) = w; } } }
    }
};

struct EpiGluBrA {
    static constexpr bool PERM = true, AFTER_DRAIN = false;
    EpiGlu g; EpiBranch b;
    __device__ __forceinline__ void operator()(const f32x4 (&acc)[2][2][4][2], const Unit& u, int wr, int wc, int fr, int fq) const { if (u.sel == 0) g(acc, u, wr, wc, fr, fq); else b.pass(acc, u, wr, wc, fr, fq, false); }
};
struct MixOrder {
    StaticOrder a, b; int G, c;
    __device__ void init(int Ma, int Na, int Mb, int Nb, int G_, int c_) { a.init(Ma, Na, G_, c_); b.init(Mb, Nb, G_, c_); G = G_; c = c_; }
    __device__ bool next(int i, Unit& u) const { const long L = (long)i * G + c; if (L < b.nwg) { b.at(L, u); u.sel = 1; return true; } if (!a.at(L - b.nwg, u)) return false; u.sel = 0; return true; }
    __device__ __forceinline__ void a_ready(const Unit&) const {}
    __device__ __forceinline__ void done(const Unit&) const {}
};
struct SelOrder {
    StaticOrder so; int sel;
    __device__ void init(int M_, int N_, int G_, int c_, int sel_) { so.init(M_, N_, G_, c_); sel = sel_; }
    __device__ bool next(int i, Unit& u) const { if (!so.next(i, u)) return false; u.sel = sel; return true; }
    __device__ __forceinline__ void a_ready(const Unit&) const {}
    __device__ __forceinline__ void done(const Unit&) const {}
};
struct PairOrder {
    StaticOrder so;
    __device__ void init(int M_, int N_, int G_, int c_) { so.init(M_, N_, G_, c_); }
    __device__ bool next(int i, Unit& u) const { if (!so.next(i >> 1, u)) return false; u.sel = i & 1; return true; }
    __device__ __forceinline__ void a_ready(const Unit&) const {}
    __device__ __forceinline__ void done(const Unit&) const {}
};
template <class Epi, class Sched, bool ALIGN_EPI = false, bool SP2 = false>
__device__ __forceinline__ void gemm_phase(PG8_LAS unsigned char* lds, const Gemm g, const Sched& S, const Epi& E) {
    const int tid = threadIdx.x, wid = __builtin_amdgcn_readfirstlane(tid >> 6), lane = tid & 63, wr = wid >> 2, wc = wid & 3, fr = lane & 15, fq = lane >> 4;
    const int K = g.K, nt = K / BK;
    unsigned voffA[2], voffB[2];
#pragma unroll
    for (int i = 0; i < 2; ++i) { int R, C; stage_rc(tid * 16 + i * 8192, R, C); const int Rb = Epi::PERM ? ((R & ~31) + perm32(R & 31)) : R;
        voffA[i] = (unsigned)(R * K + C) * 2u; voffB[i] = (unsigned)(Rb * K + C) * 2u; }
    const size_t kstep = (size_t)(BK * 2);
    const size_t hstep = (size_t)HALF * K * 2;
    const size_t tstep = 2 * hstep;
    const unsigned ldsw = (unsigned)wid * 1024u;
    const int aoff = lds_byte(wr * 64 + fr, fq * 8), boff = lds_byte(wc * 32 + fr, fq * 8);
#define PG8_SA(b, h) (((b) * 2 + (h)) * HTB)
#define PG8_SB(b, h) ((4 + (b) * 2 + (h)) * HTB)
#define PG8_STAGE(bufoff, gbase, voff) do { _Pragma("unroll") for (int _i = 0; _i < 2; ++_i) \
        __builtin_amdgcn_global_load_lds((const unsigned*)((const char*)(gbase) + (voff)[_i]), (PG8_LAS unsigned*)(lds + (bufoff) + ldsw + _i * 8192), 16, 0, 0); } while (0)
#define PG8_LDA(dst, b, h) do { _Pragma("unroll") for (int m = 0; m < 4; ++m) _Pragma("unroll") for (int k = 0; k < 2; ++k) dst[m][k] = *(const PG8_LAS bf16x8*)(lds + PG8_SA(b, h) + aoff + m * 2048 + k * 1024); } while (0)
#define PG8_LDB(dst, b, h) do { _Pragma("unroll") for (int n = 0; n < 2; ++n) _Pragma("unroll") for (int k = 0; k < 2; ++k) dst[n][k] = *(const PG8_LAS bf16x8*)(lds + PG8_SB(b, h) + boff + n * 2048 + k * 1024); } while (0)
#define PG8_MMA(ai, bj, At, Bt) do { __builtin_amdgcn_s_setprio(1); _Pragma("unroll") for (int m = 0; m < 4; ++m) _Pragma("unroll") for (int n = 0; n < 2; ++n) _Pragma("unroll") for (int k = 0; k < 2; ++k) \
        acc[ai][bj][m][n] = __builtin_amdgcn_mfma_f32_16x16x32_bf16(Bt[n][k], At[m][k], acc[ai][bj][m][n], 0, 0, 0); __builtin_amdgcn_s_setprio(0); } while (0)
#define PG8_WAIT_V(n) asm volatile("s_waitcnt vmcnt(" #n ")" ::: "memory")
#define PG8_WAIT_L(n) asm volatile("s_waitcnt lgkmcnt(" #n ")" ::: "memory")
#define PG8_BAR __builtin_amdgcn_s_barrier()
#define PG8_SCHED __builtin_amdgcn_sched_barrier(0)
    Unit cur, nxt; int ui = 0;
    if (!S.next(0, cur)) return;
    f32x4 acc[2][2][4][2];
#pragma unroll
    for (int a = 0; a < 2; ++a)
#pragma unroll
        for (int b = 0; b < 2; ++b)
#pragma unroll
            for (int m = 0; m < 4; ++m)
#pragma unroll
                for (int n = 0; n < 2; ++n) acc[a][b][m][n] = (f32x4){0.f, 0.f, 0.f, 0.f};
    bf16x8 At[4][2], B0[2][2], B1[2][2];
    const char* cA = (const char*)(cur.sel ? g.A2 : g.A) + (size_t)cur.pm * tstep; const char* cB = (const char*)(cur.sel ? g.Bt2 : g.Bt) + (size_t)cur.pn * tstep;
    S.a_ready(cur);
    if constexpr (SP2) {
        PG8_STAGE(PG8_SB(0, 0), cB, voffB); PG8_STAGE(PG8_SB(0, 1), cB + hstep, voffB); PG8_STAGE(PG8_SA(0, 0), cA, voffA); PG8_STAGE(PG8_SA(0, 1), cA + hstep, voffA);
        if (wr == 1) PG8_BAR;
        PG8_WAIT_V(2); PG8_BAR;
        PG8_STAGE(PG8_SB(1, 0), cB + kstep, voffB); PG8_STAGE(PG8_SA(1, 0), cA + kstep, voffA); PG8_STAGE(PG8_SB(1, 1), cB + hstep + kstep, voffB);
        PG8_WAIT_V(6); PG8_BAR;
    } else {
        PG8_STAGE(PG8_SB(0, 0), cB, voffB); PG8_STAGE(PG8_SA(0, 0), cA, voffA); PG8_STAGE(PG8_SB(0, 1), cB + hstep, voffB); PG8_STAGE(PG8_SA(0, 1), cA + hstep, voffA);
        if (wr == 1) PG8_BAR;
        PG8_WAIT_V(4); PG8_BAR;
        PG8_STAGE(PG8_SB(1, 0), cB + kstep, voffB); PG8_STAGE(PG8_SA(1, 0), cA + kstep, voffA); PG8_STAGE(PG8_SB(1, 1), cB + hstep + kstep, voffB);
        PG8_WAIT_V(6); PG8_BAR;
    }
    for (;;) {
        const bool has_next = S.next(ui + 1, nxt);
        const char* nA = has_next ? (const char*)(nxt.sel ? g.A2 : g.A) + (size_t)nxt.pm * tstep : cA; const char* nB = has_next ? (const char*)(nxt.sel ? g.Bt2 : g.Bt) + (size_t)nxt.pn * tstep : cB;
        for (int t = 0; t < nt; t += 2) {
            const bool last = (t == nt - 2);
            const char* a1 = cA + (size_t)(t + 1) * kstep;
            const char* a2 = last ? nA : cA + (size_t)(t + 2) * kstep; const char* b2 = last ? nB : cB + (size_t)(t + 2) * kstep;
            const char* a3 = a2 + kstep; const char* b3 = b2 + kstep;
            if (last && has_next) S.a_ready(nxt);
            if constexpr (SP2) {
            PG8_LDB(B0, 0, 0); PG8_LDB(B1, 0, 1); PG8_SCHED; PG8_LDA(At, 0, 0); PG8_STAGE(PG8_SA(1, 1), a1 + hstep, voffA);
            PG8_WAIT_V(8); PG8_WAIT_L(0); PG8_BAR; PG8_MMA(0, 0, At, B0); PG8_MMA(0, 1, At, B1); PG8_BAR; PG8_SCHED;
            PG8_LDA(At, 0, 1); PG8_STAGE(PG8_SB(0, 0), b2, voffB); PG8_STAGE(PG8_SB(0, 1), b2 + hstep, voffB); PG8_STAGE(PG8_SA(0, 0), a2, voffA);
            PG8_WAIT_V(8); PG8_WAIT_L(0); PG8_BAR; PG8_MMA(1, 0, At, B0); PG8_MMA(1, 1, At, B1); PG8_BAR; PG8_SCHED;
            PG8_LDB(B0, 1, 0); PG8_LDB(B1, 1, 1); PG8_SCHED; PG8_LDA(At, 1, 0); PG8_STAGE(PG8_SA(0, 1), a2 + hstep, voffA);
            PG8_WAIT_V(8); PG8_WAIT_L(0); PG8_BAR; PG8_MMA(0, 0, At, B0); PG8_MMA(0, 1, At, B1); PG8_BAR; PG8_SCHED;
            PG8_LDA(At, 1, 1); PG8_STAGE(PG8_SB(1, 0), b3, voffB); PG8_STAGE(PG8_SB(1, 1), b3 + hstep, voffB); PG8_STAGE(PG8_SA(1, 0), a3, voffA);
            PG8_WAIT_V(8); PG8_WAIT_L(0); PG8_BAR; PG8_MMA(1, 0, At, B0); PG8_MMA(1, 1, At, B1); PG8_BAR; PG8_SCHED;
            } else {
            PG8_LDB(B0, 0, 0); PG8_SCHED; PG8_LDA(At, 0, 0); PG8_STAGE(PG8_SA(1, 1), a1 + hstep, voffA);
            PG8_WAIT_L(8); PG8_BAR; PG8_WAIT_L(0); PG8_MMA(0, 0, At, B0); PG8_BAR; PG8_SCHED;
            PG8_LDB(B1, 0, 1); PG8_STAGE(PG8_SB(0, 0), b2, voffB);
            PG8_BAR; PG8_WAIT_L(0); PG8_MMA(0, 1, At, B1); PG8_BAR;
            PG8_LDA(At, 0, 1); PG8_STAGE(PG8_SA(0, 0), a2, voffA);
            PG8_BAR; PG8_WAIT_L(0); PG8_MMA(1, 0, At, B0); PG8_BAR; PG8_SCHED;
            PG8_STAGE(PG8_SB(0, 1), b2 + hstep, voffB);
            PG8_WAIT_V(6); PG8_BAR; PG8_MMA(1, 1, At, B1); PG8_BAR;
            PG8_LDB(B0, 1, 0); PG8_SCHED; PG8_LDA(At, 1, 0); PG8_STAGE(PG8_SA(0, 1), a2 + hstep, voffA);
            PG8_WAIT_L(8); PG8_BAR; PG8_WAIT_L(0); PG8_MMA(0, 0, At, B0); PG8_BAR; PG8_SCHED;
            PG8_LDB(B1, 1, 1); PG8_STAGE(PG8_SB(1, 0), b3, voffB);
            PG8_BAR; PG8_WAIT_L(0); PG8_MMA(0, 1, At, B1); PG8_BAR;
            PG8_LDA(At, 1, 1); PG8_STAGE(PG8_SA(1, 0), a3, voffA);
            PG8_BAR; PG8_WAIT_L(0); PG8_MMA(1, 0, At, B0); PG8_BAR; PG8_SCHED;
            PG8_STAGE(PG8_SB(1, 1), b3 + hstep, voffB);
            PG8_WAIT_V(6); PG8_BAR; PG8_MMA(1, 1, At, B1); PG8_BAR;
            }
        }
        if constexpr (ALIGN_EPI) { if (wr == 0) PG8_BAR; }
        if constexpr (!Epi::AFTER_DRAIN) { E(acc, cur, wr, wc, fr, fq); S.done(cur); }
        if (!has_next) break;
#pragma unroll
        for (int a = 0; a < 2; ++a)
#pragma unroll
            for (int b = 0; b < 2; ++b)
#pragma unroll
                for (int m = 0; m < 4; ++m)
#pragma unroll
                    for (int n = 0; n < 2; ++n) acc[a][b][m][n] = (f32x4){0.f, 0.f, 0.f, 0.f};
        cur = nxt; cA = nA; cB = nB; ++ui;
        if constexpr (ALIGN_EPI) { if (wr == 1) PG8_BAR; }
    }
    PG8_WAIT_V(0);
    if constexpr (!ALIGN_EPI) { if (wr == 0) PG8_BAR; }
    PG8_BAR;
    if constexpr (Epi::AFTER_DRAIN) { E.fused(acc, cur, wr, wc, fr, fq, lds, wid, lane); S.done(cur); }
#undef PG8_SA
#undef PG8_SB
#undef PG8_STAGE
#undef PG8_LDA
#undef PG8_LDB
#undef PG8_MMA
#undef PG8_WAIT_V
#undef PG8_WAIT_L
#undef PG8_BAR
#undef PG8_SCHED
}
}

namespace sba {
typedef short bf16x8 __attribute__((ext_vector_type(8)));
typedef short s16x4 __attribute__((ext_vector_type(4)));
typedef float f32x16 __attribute__((ext_vector_type(16)));
typedef unsigned u32x4 __attribute__((ext_vector_type(4)));
typedef unsigned short bf16_t;
typedef __attribute__((address_space(3))) const char* lds_cptr;
typedef __attribute__((address_space(3))) char* lds_ptr;
constexpr int DM = 512, SLOTB = 8192, LK = 0, LV = 2 * SLOTB, LOST = 4 * SLOTB, LBYTES = LOST + 8 * 4096;
__device__ __forceinline__ void glds16(const void* gsrc, unsigned lds_dst) { unsigned keep;
    asm volatile("s_mov_b32 %0, m0\n\ts_mov_b32 m0, %2\n\ts_nop 0\n\tglobal_load_lds_dwordx4 %1, off\n\ts_mov_b32 m0, %0" : "=&s"(keep) : "v"(gsrc), "s"(lds_dst) : "memory"); }
typedef float f32x2_t __attribute__((ext_vector_type(2))); typedef __bf16 bf16x2_t __attribute__((ext_vector_type(2)));
__device__ __forceinline__ unsigned cvtpk(float lo, float hi) { f32x2_t v = {lo, hi}; bf16x2_t b = __builtin_convertvector(v, bf16x2_t); return __builtin_bit_cast(unsigned, b); }
#define SBA_WAIT_BAR() asm volatile("s_waitcnt vmcnt(0) lgkmcnt(0)\n\ts_barrier" ::: "memory")

__device__ __forceinline__ void qkt(f32x16& p0, f32x16& p1, lds_cptr kp, const bf16x8* qr, const f32x16& cin) {
#pragma unroll
    for (int d0 = 0; d0 < 4; ++d0) {
        const bf16x8 b0 = *(const __attribute__((address_space(3))) bf16x8*)(kp + d0 * 2048);
        const bf16x8 b1 = *(const __attribute__((address_space(3))) bf16x8*)(kp + d0 * 2048 + 512);
        if (d0 == 0) { p0 = __builtin_amdgcn_mfma_f32_32x32x16_bf16(b0, qr[0], cin, 0, 0, 0); p1 = __builtin_amdgcn_mfma_f32_32x32x16_bf16(b1, qr[0], cin, 0, 0, 0); }
        else { p0 = __builtin_amdgcn_mfma_f32_32x32x16_bf16(b0, qr[d0], p0, 0, 0, 0); p1 = __builtin_amdgcn_mfma_f32_32x32x16_bf16(b1, qr[d0], p1, 0, 0, 0); } }
}
__device__ __forceinline__ void pv(f32x16* o, int vb, bf16x8 pa0, bf16x8 pa1, bf16x8 pa2, bf16x8 pa3) {
#pragma unroll
    for (int d0 = 0; d0 < 2; ++d0) { s16x4 lo[4], hi[4];
#pragma unroll
        for (int ks = 0; ks < 4; ++ks) {
            asm volatile("ds_read_b64_tr_b16 %0,%1 offset:%c2" : "=&v"(lo[ks]) : "v"(vb), "i"(d0 * 4096 + ks * 1024) : "memory");
            asm volatile("ds_read_b64_tr_b16 %0,%1 offset:%c2" : "=&v"(hi[ks]) : "v"(vb), "i"(d0 * 4096 + ks * 1024 + 512) : "memory"); }
        asm volatile("s_waitcnt lgkmcnt(0)" ::: "memory"); __builtin_amdgcn_sched_barrier(0);
#define SBA_PK(k) (bf16x8){lo[k][0], lo[k][1], lo[k][2], lo[k][3], hi[k][0], hi[k][1], hi[k][2], hi[k][3]}
        o[d0] = __builtin_amdgcn_mfma_f32_32x32x16_bf16(pa0, SBA_PK(0), o[d0], 0, 0, 0);
        o[d0] = __builtin_amdgcn_mfma_f32_32x32x16_bf16(pa1, SBA_PK(1), o[d0], 0, 0, 0);
        o[d0] = __builtin_amdgcn_mfma_f32_32x32x16_bf16(pa2, SBA_PK(2), o[d0], 0, 0, 0);
        o[d0] = __builtin_amdgcn_mfma_f32_32x32x16_bf16(pa3, SBA_PK(3), o[d0], 0, 0, 0);
#undef SBA_PK
    }
}
template <bool MASK>
__device__ __forceinline__ void tile_compute(lds_cptr kp, int vb, const bf16x8* qr, const f32x16& cin, f32x16* o, float& C, int hi, int kbase, int qrel) {
        f32x16 p0, p1;
        qkt(p0, p1, kp, qr, cin);
#pragma unroll
        for (int r = 0; r < 16; ++r) { p0[r] = __builtin_fminf(p0[r], 60.0f); p1[r] = __builtin_fminf(p1[r], 60.0f); }
        if (MASK) { const int kb = kbase + 4 * hi;
#pragma unroll
            for (int r = 0; r < 16; ++r) { const int kv = kb + (r & 3) + 8 * (r >> 2); if (kv >= qrel) p0[r] = -__builtin_inff(); if (kv + 32 >= qrel) p1[r] = -__builtin_inff(); } }
        f32x16 e0, e1;
#pragma unroll
        for (int r = 0; r < 16; ++r) { e0[r] = __builtin_amdgcn_exp2f(p0[r]); e1[r] = __builtin_amdgcn_exp2f(p1[r]); }
#pragma unroll
        for (int r = 0; r < 16; ++r) { p0[r] = __builtin_amdgcn_rcpf(1.0f + e0[r]); p1[r] = __builtin_amdgcn_rcpf(1.0f + e1[r]); }
        float cgprev = 1.0f;
#pragma unroll
        for (int L = 0; L < 8; ++L) {
            f32x16& R = (L < 4) ? p1 : p0; f32x16& E = (L < 4) ? e1 : e0; const int g4 = 4 * (3 - (L & 3));
            R[g4 + 2] *= R[g4 + 3]; R[g4 + 1] *= R[g4 + 2]; R[g4 + 0] *= R[g4 + 1];
            const float cg = cgprev * R[g4 + 0];
            auto rr = __builtin_amdgcn_permlane32_swap(__float_as_uint(cg), __float_as_uint(cgprev), false, false);
            const float mL = hi ? __uint_as_float(rr[0]) : __uint_as_float(rr[1]);
            const float pre = (C * cgprev) * mL;
            E[g4 + 3] *= R[g4 + 3] * pre; E[g4 + 2] *= R[g4 + 2] * pre; E[g4 + 1] *= R[g4 + 1] * pre; E[g4 + 0] *= R[g4 + 0] * pre;
            cgprev = cg;
        }
        { auto rr = __builtin_amdgcn_permlane32_swap(__float_as_uint(cgprev), __float_as_uint(cgprev), false, false); C = C * (__uint_as_float(rr[0]) * __uint_as_float(rr[1])); }
        u32x4 pw0, pw1, pw2, pw3;
        pw0 = (u32x4){cvtpk(e0[0], e0[1]), cvtpk(e0[2], e0[3]), cvtpk(e0[4], e0[5]), cvtpk(e0[6], e0[7])};
        pw1 = (u32x4){cvtpk(e0[8], e0[9]), cvtpk(e0[10], e0[11]), cvtpk(e0[12], e0[13]), cvtpk(e0[14], e0[15])};
        pw2 = (u32x4){cvtpk(e1[0], e1[1]), cvtpk(e1[2], e1[3]), cvtpk(e1[4], e1[5]), cvtpk(e1[6], e1[7])};
        pw3 = (u32x4){cvtpk(e1[8], e1[9]), cvtpk(e1[10], e1[11]), cvtpk(e1[12], e1[13]), cvtpk(e1[14], e1[15])};
        __builtin_amdgcn_sched_barrier(0);
        pv(o, vb, __builtin_bit_cast(bf16x8, pw0), __builtin_bit_cast(bf16x8, pw1), __builtin_bit_cast(bf16x8, pw2), __builtin_bit_cast(bf16x8, pw3));
}
__device__ __forceinline__ void unit(int b, int h, int qb, const bf16_t* Q, const bf16_t* __restrict__ K, const bf16_t* __restrict__ V, bf16_t* O, float bias2, lds_ptr shm) {
    const int tid = threadIdx.x, lane = tid & 63, r32 = lane & 31, hi = lane >> 5; const int wid = __builtin_amdgcn_readfirstlane(tid >> 6);
    const long rowbase = (long)b * SEQ; const int q0 = qb * 256;
    const bf16_t* Qw = Q + (rowbase + q0 + wid * 32) * DM + h * HD;
    const bf16_t* Kh = K + rowbase * DM + h * HD, * Vh = V + rowbase * DM + h * HD;
    const unsigned lds0 = (unsigned)(uintptr_t)shm;
    const bf16_t* ksrc = Kh + (long)lane * DM + wid * 8;
    const bf16_t* vsrc = Vh + (long)(16 * (wid & 3) + (lane >> 2)) * DM + (wid >> 2) * 32 + (lane & 3) * 8;
    const unsigned kdst = lds0 + LK + wid * 1024, vdst = lds0 + LV + wid * 1024;
#define SBA_DMA_K(t, slot) glds16(ksrc + (long)(t) * 64 * DM, (unsigned)__builtin_amdgcn_readfirstlane(kdst + (slot)))
#define SBA_DMA_V(t, slot) glds16(vsrc + (long)(t) * 64 * DM, (unsigned)__builtin_amdgcn_readfirstlane(vdst + (slot)))
    const int vb0 = (int)(lds0 + LV) + ((lane >> 4) & 1) * 32 + (lane & 3) * 8 + (4 * hi + ((lane & 15) >> 2)) * 64;
    const lds_cptr kp0 = (lds_cptr)shm + LK + hi * 1024 + r32 * 16;
    const int NT = (q0 + 256) / 64;
    SBA_DMA_K(NT - 1, ((NT - 1) & 1) * SLOTB); SBA_DMA_V(NT - 1, ((NT - 1) & 1) * SLOTB);
    bf16x8 qr[4];
#pragma unroll
    for (int d0 = 0; d0 < 4; ++d0) qr[d0] = *reinterpret_cast<const bf16x8*>(&Qw[(long)r32 * DM + d0 * 16 + hi * 8]);
    f32x16 o[2]; o[0] = f32x16{}; o[1] = f32x16{};
    f32x16 cin;
#pragma unroll
    for (int r = 0; r < 16; ++r) cin[r] = bias2;
    float C = 1.0f;
    const int qrel = wid * 32 + r32;
    for (int t = NT - 1; t >= 0; --t) {
        const int slot = (t & 1) * SLOTB;
        SBA_WAIT_BAR();
        if (t > 0) { SBA_DMA_K(t - 1, slot ^ SLOTB); SBA_DMA_V(t - 1, slot ^ SLOTB); }
        const int jb = t - (NT - 4);
        if (jb >= 0 && 64 * jb >= 32 * wid + 32) continue;
        if (jb >= 0) tile_compute<true>(kp0 + slot, vb0 + slot, qr, cin, o, C, hi, 64 * jb, qrel); else tile_compute<false>(kp0 + slot, vb0 + slot, qr, cin, o, C, hi, 0, qrel);
    }
    bf16_t* Ow = O + (rowbase + q0 + wid * 32) * DM + h * HD;
    { __attribute__((address_space(3))) bf16_t* stg = (__attribute__((address_space(3))) bf16_t*)(shm + LOST) + wid * 2048;
#pragma unroll
        for (int r = 0; r < 16; ++r) { const int orow = (r & 3) + 8 * (r >> 2) + 4 * hi;
#pragma unroll
            for (int d0 = 0; d0 < 2; ++d0) stg[orow * 64 + d0 * 32 + r32] = (bf16_t)(cvtpk(o[d0][r], 0.f) & 0xffffu); }
        asm volatile("s_waitcnt lgkmcnt(0)" ::: "memory");
#pragma unroll
        for (int i = 0; i < 4; ++i) { const int row = i * 8 + (lane >> 3), ch = lane & 7; const u32x4 v = *(const __attribute__((address_space(3))) u32x4*)(stg + row * 64 + ch * 8); *(u32x4*)(Ow + (long)row * DM + ch * 8) = v; } }
    asm volatile("s_waitcnt lgkmcnt(0)\n\ts_barrier" ::: "memory");
#undef SBA_DMA_K
#undef SBA_DMA_V
}

__device__ __forceinline__ void fill_slots(const float* kbase, const float* vbase, int nvalid, lds_ptr kslot, lds_ptr vslot, int lane) {
    const int k4 = lane & 3, m = lane >> 2;
    typedef float f32x4 __attribute__((ext_vector_type(4)));
    typedef unsigned u32x2 __attribute__((ext_vector_type(2)));
    const int kofs = (m >> 1) * 1024 + (m & 1) * 8, vofs = (m >> 3) * 4096 + (m & 7) * 8;
    f32x4 kr[16], va[8];
#pragma unroll
    for (int j = 0; j < 16; ++j) { const int key = 4 * j + k4; const bool ok = key < nvalid; kr[j] = *(const f32x4*)(kbase + (size_t)(ok ? key : 0) * 512 + 4 * m); if (!ok) kr[j] = (f32x4){0.f, 0.f, 0.f, 0.f}; }
#pragma unroll
    for (int j = 0; j < 8; ++j) { const int key = 4 * j + k4; const bool ok = key < nvalid; va[j] = *(const f32x4*)(vbase + (size_t)(ok ? key : 0) * 512 + 4 * m); if (!ok) va[j] = (f32x4){0.f, 0.f, 0.f, 0.f}; }
    __builtin_amdgcn_sched_barrier(0);
#pragma unroll
    for (int j = 0; j < 16; ++j) { const int key = 4 * j + k4; *(__attribute__((address_space(3))) u32x2*)(kslot + kofs + key * 16) = (u32x2){cvtpk(kr[j][0], kr[j][1]), cvtpk(kr[j][2], kr[j][3])}; }
    __builtin_amdgcn_sched_barrier(0);
    f32x4 vb2[8];
#pragma unroll
    for (int j = 0; j < 8; ++j) { const int key = 4 * (j + 8) + k4; const bool ok = key < nvalid; vb2[j] = *(const f32x4*)(vbase + (size_t)(ok ? key : 0) * 512 + 4 * m); if (!ok) vb2[j] = (f32x4){0.f, 0.f, 0.f, 0.f}; }
    __builtin_amdgcn_sched_barrier(0);
#pragma unroll
    for (int j = 0; j < 8; ++j) { const int key = 4 * j + k4; *(__attribute__((address_space(3))) u32x2*)(vslot + vofs + (key >> 4) * 1024 + (key & 15) * 64) = (u32x2){cvtpk(va[j][0], va[j][1]), cvtpk(va[j][2], va[j][3])}; }
#pragma unroll
    for (int j = 0; j < 8; ++j) { const int key = 4 * (j + 8) + k4; *(__attribute__((address_space(3))) u32x2*)(vslot + vofs + (key >> 4) * 1024 + (key & 15) * 64) = (u32x2){cvtpk(vb2[j][0], vb2[j][1]), cvtpk(vb2[j][2], vb2[j][3])}; }
    asm volatile("s_waitcnt lgkmcnt(0)" ::: "memory");
}
__device__ __forceinline__ void sample_unit(int b, int hg, const bf16_t* Q, const float* cache_k, const float* cache_v, const int* ptab, const float* new_k, const float* new_v, const float* sb_bias, bf16_t* O, lds_ptr shm) {
    const int tid = threadIdx.x, lane = tid & 63, r32 = lane & 31, hi = lane >> 5; const int w = __builtin_amdgcn_readfirstlane(tid >> 6);
    const int h = hg * 4 + (w & 3), half = w >> 2, row0 = NP + b * ST;
    const lds_ptr kslot = shm + w * 16384, vslot = kslot + 8192;
    const lds_cptr kp = (lds_cptr)kslot + hi * 1024 + r32 * 16;
    const int vb = (int)(unsigned)(uintptr_t)vslot + ((lane >> 4) & 1) * 32 + (lane & 3) * 8 + (4 * hi + ((lane & 15) >> 2)) * 64;
    bf16x8 qr[4];
#pragma unroll
    for (int d0 = 0; d0 < 4; ++d0) { qr[d0] = (bf16x8){0, 0, 0, 0, 0, 0, 0, 0}; if (r32 < ST) qr[d0] = *reinterpret_cast<const bf16x8*>(&Q[(size_t)(row0 + r32) * DM + h * HD + d0 * 16 + hi * 8]); }
    f32x16 o[2]; o[0] = f32x16{}; o[1] = f32x16{};
    f32x16 cin; const float bias2 = sb_bias[h] * LOG2E;
#pragma unroll
    for (int r = 0; r < 16; ++r) cin[r] = bias2;
    float C = 1.0f;
    if (half == 1) { fill_slots(new_k + h * HD, new_v + h * HD, ST, kslot, vslot, lane); tile_compute<true>(kp, vb, qr, cin, o, C, hi, 0, r32); }
#pragma unroll 1
    for (int tt = 15; tt >= 0; --tt) {
        const int pos0 = 1024 * half + 64 * tt; const int page = __builtin_amdgcn_readfirstlane(ptab[b * NPAGES + (pos0 >> 7)]);
        const size_t base = ((size_t)page * PAGE + (pos0 & 127)) * 512 + h * HD;
        fill_slots(cache_k + base, cache_v + base, 64, kslot, vslot, lane);
        tile_compute<false>(kp, vb, qr, cin, o, C, hi, 0, r32);
    }
    __attribute__((address_space(3))) float* park = (__attribute__((address_space(3))) float*)(shm + (w & 3) * 16384);
    __attribute__((address_space(3))) float* cpark = (__attribute__((address_space(3))) float*)(shm + (w & 3) * 16384 + 4096);
    if (half == 0) {
#pragma unroll
        for (int r = 0; r < 4; ++r)
#pragma unroll
            for (int d0 = 0; d0 < 2; ++d0) park[(4 * hi + r) * 64 + d0 * 32 + r32] = o[d0][r]; }
    asm volatile("s_waitcnt lgkmcnt(0)\n\ts_barrier" ::: "memory");
    if (half == 1) {
        if (hi == 0 && r32 < ST) cpark[r32] = C;
        asm volatile("s_waitcnt lgkmcnt(0)" ::: "memory");
#pragma unroll
        for (int r = 0; r < 4; ++r) { const int q = 4 * hi + r; const float cq = cpark[q];
#pragma unroll
            for (int d0 = 0; d0 < 2; ++d0) { const float v = o[d0][r] + cq * park[q * 64 + d0 * 32 + r32]; O[(size_t)(row0 + q) * DM + h * HD + d0 * 32 + r32] = (bf16_t)(cvtpk(v, 0.f) & 0xffffu); } } }
    asm volatile("s_waitcnt lgkmcnt(0)\n\ts_barrier" ::: "memory");
}

__device__ __forceinline__ void sample_job(int b, int h, const bf16_t* Q, const float* cache_k, const float* cache_v, const int* ptab, const float* new_k, const float* new_v, const float* sb_bias, bf16_t* O, lds_ptr kslot, int lane) {
    const int r32 = lane & 31, hi = lane >> 5, row0 = NP + b * ST;
    const lds_ptr vslot = kslot + 8192;
    const lds_cptr kp = (lds_cptr)kslot + hi * 1024 + r32 * 16;
    const int vb = (int)(unsigned)(uintptr_t)vslot + ((lane >> 4) & 1) * 32 + (lane & 3) * 8 + (4 * hi + ((lane & 15) >> 2)) * 64;
    bf16x8 qr[4];
#pragma unroll
    for (int d0 = 0; d0 < 4; ++d0) { qr[d0] = (bf16x8){0, 0, 0, 0, 0, 0, 0, 0}; if (r32 < ST) qr[d0] = *reinterpret_cast<const bf16x8*>(&Q[(size_t)(row0 + r32) * DM + h * HD + d0 * 16 + hi * 8]); }
    f32x16 o[2]; o[0] = f32x16{}; o[1] = f32x16{};
    f32x16 cin; const float bias2 = sb_bias[h] * LOG2E;
#pragma unroll
    for (int r = 0; r < 16; ++r) cin[r] = bias2;
    float C = 1.0f;
    fill_slots(new_k + h * HD, new_v + h * HD, ST, kslot, vslot, lane); tile_compute<true>(kp, vb, qr, cin, o, C, hi, 0, r32);
#pragma unroll 1
    for (int tt = PAST / 64 - 1; tt >= 0; --tt) {
        const int pos0 = 64 * tt; const int page = __builtin_amdgcn_readfirstlane(ptab[b * NPAGES + (pos0 >> 7)]);
        const size_t base = ((size_t)page * PAGE + (pos0 & 127)) * 512 + h * HD;
        fill_slots(cache_k + base, cache_v + base, 64, kslot, vslot, lane);
        tile_compute<false>(kp, vb, qr, cin, o, C, hi, 0, r32);
    }
#pragma unroll
    for (int r = 0; r < 4; ++r) { const int q = 4 * hi + r;
#pragma unroll
        for (int d0 = 0; d0 < 2; ++d0) O[(size_t)(row0 + q) * DM + h * HD + d0 * 32 + r32] = (bf16_t)(cvtpk(o[d0][r], 0.f) & 0xffffu); }
}
#undef SBA_WAIT_BAR
}

constexpr int NWAVES = 8;
#ifndef MK_PER_PHASE
#define MK_PER_PHASE 0
#endif
constexpr int N_PHASES = 16;

constexpr size_t MiB = 1u << 20;
constexpr size_t WS_CTL = 0, CTL_ZERO_BYTES = 1 * MiB;
constexpr size_t WS_ADA_T = 2 * MiB;
constexpr size_t WS_W1IN_T = 20 * MiB;
constexpr size_t WS_W1OUT_T = 31 * MiB;
constexpr size_t WS_WIN_T = 37 * MiB;
constexpr size_t WS_GLU_T = 45 * MiB;
constexpr size_t WS_WA_T = 46 * MiB;
constexpr size_t WS_WB_T = 47 * MiB;
constexpr size_t WS_WOUT_T = 48 * MiB;
constexpr size_t WS_W2IN_T = 50 * MiB;
constexpr size_t WS_W2OUT_T = 61 * MiB;
constexpr size_t WS_SC = 67 * MiB;
constexpr size_t WS_MOD = 68 * MiB;
constexpr size_t WS_END = 73 * MiB;
constexpr size_t WS_U = 80 * MiB;
constexpr size_t WS_HID = 116 * MiB;
constexpr size_t WS_H = 212 * MiB;
constexpr size_t WS_Q = 280 * MiB;
constexpr size_t WS_KB = 298 * MiB, WS_VB = 316 * MiB;
constexpr size_t WS_S = 334 * MiB;
constexpr size_t WS_Y = 368 * MiB;
constexpr size_t WS_GA = 402 * MiB, WS_GB = 436 * MiB;
constexpr size_t WS_OA = 470 * MiB, WS_ZG = 488 * MiB, WS_OB = 506 * MiB;
constexpr size_t WS_TMP = 524 * MiB;
constexpr size_t WS_MRG = 592 * MiB;
constexpr size_t WS_KT = 628 * MiB;
constexpr size_t WS_ET = 630 * MiB;
constexpr size_t WS_FT = 638 * MiB;
constexpr size_t WS_AU = 646 * MiB;
constexpr size_t WS_AC = 662 * MiB;
constexpr size_t WS_TOTAL = 664 * MiB;
constexpr size_t WS_ZERO = 256 * 1024;
constexpr int CW_BAR = 4096;

constexpr int RING_OFF = 0, RING_BYTES = 131072;
constexpr int LDSCTL_OFF = RING_BYTES, MISC_OFF = LDSCTL_OFF + 320;
constexpr int LDS_BYTES = 147456;

#define GAS __attribute__((address_space(1)))
#define LAS __attribute__((address_space(3)))
typedef unsigned short bf16;
typedef unsigned v4u __attribute__((ext_vector_type(4)));
typedef float f32x4 __attribute__((ext_vector_type(4)));
typedef short bf16x8 __attribute__((ext_vector_type(8)));
typedef GAS unsigned gu32;
typedef GAS unsigned long long gu64;
#define RLX_AGENT __ATOMIC_RELAXED, __HIP_MEMORY_SCOPE_AGENT
#define LDS_WAIT() asm volatile("s_waitcnt lgkmcnt(0)" ::: "memory")
#define VM_WAIT() asm volatile("s_waitcnt vmcnt(0)" ::: "memory")
__device__ __forceinline__ unsigned long long rt() { return __builtin_amdgcn_s_memrealtime(); }
__device__ __forceinline__ unsigned f2bf(float f) { unsigned u = __builtin_bit_cast(unsigned, f); return (u + 0x7fffu + ((u >> 16) & 1u)) >> 16; }
__device__ __forceinline__ unsigned pk2(float lo, float hi) { return f2bf(lo) | (f2bf(hi) << 16); }

#define XB_TMO      128
#define XB_XCNT(j)  (256  + 64 * (j))
#define XB_XSUB(j)  (1280 + 64 * (j))
#define XB_XGEN(j)  (2304 + 64 * (j))
#define XB_TOP      3328
#define XB_TOPGEN   3392
#define XCD_BAR_WORDS 3456
#define XB_SPIN_CAP (1u << 18)

__device__ __forceinline__ unsigned xb_ld(unsigned* p)              { return __hip_atomic_load(p, __ATOMIC_RELAXED, __HIP_MEMORY_SCOPE_AGENT); }
__device__ __forceinline__ unsigned xb_add(unsigned* p, unsigned v) { return __hip_atomic_fetch_add(p, v, __ATOMIC_RELAXED, __HIP_MEMORY_SCOPE_AGENT); }
__device__ __forceinline__ unsigned xb_xcc_id() { return (unsigned)__builtin_amdgcn_s_getreg((3 << 11) | 20) & 0xFu; }
#define XB_SPIN(cond, bar) do { unsigned _sp = 0; while (cond) { __builtin_amdgcn_s_sleep(1); \
    if ((++_sp & 255u) == 0u) { if (xb_ld(&(bar)[XB_TMO])) break; if (_sp > XB_SPIN_CAP) { atomicAdd(&(bar)[XB_TMO], 1u); break; } } } } while (0)

struct XcdBarrier {
    unsigned* bar; unsigned x;
    volatile LAS unsigned* st;
};

__device__ __forceinline__ XcdBarrier xcd_barrier_post(unsigned* bar, volatile LAS unsigned* st) {
    XcdBarrier b; b.bar = bar; b.x = xb_xcc_id(); b.st = st;
    if (threadIdx.x == 0) (void)xb_add(&bar[XB_XCNT(b.x)], 1u);
    return b;
}
__device__ __forceinline__ void xcd_barrier_complete(unsigned* bar, unsigned x, unsigned& nloc, unsigned& nx) {
    const unsigned G = gridDim.x * gridDim.y * gridDim.z;
    unsigned sum, cnt, mine, sp = 0u;
    for (;;) {
        sum = 0u; cnt = 0u; mine = 0u;
#pragma unroll
        for (unsigned j = 0; j < 16; ++j) { const unsigned c = xb_ld(&bar[XB_XCNT(j)]); sum += c; cnt += (c > 0u) ? 1u : 0u; mine = (j == x) ? c : mine; }
        if (sum == G) break;
        __builtin_amdgcn_s_sleep(1);
        if ((++sp & 255u) == 0u) { if (xb_ld(&bar[XB_TMO])) break; if (sp > XB_SPIN_CAP) { atomicAdd(&bar[XB_TMO], 1u); break; } }
    }
    nloc = mine > 0u ? mine : 1u; nx = cnt > 0u ? cnt : 1u;
}

__device__ __forceinline__ void xcd_barrier(const XcdBarrier& b) {
    asm volatile("s_waitcnt vmcnt(0)" ::: "memory");
    __syncthreads();
    if (threadIdx.x == 0) {
        unsigned* bar = b.bar;
        __builtin_amdgcn_s_waitcnt(0);
        unsigned nloc = b.st[0], nx = b.st[1];
        if (nloc == 0u) { xcd_barrier_complete(bar, b.x, nloc, nx); b.st[0] = nloc; b.st[1] = nx; }
        const unsigned old = xb_add(&bar[XB_XSUB(b.x)], 1u);
        const unsigned gen = old / nloc;
        if (old + 1u == (gen + 1u) * nloc) {
            __builtin_amdgcn_fence(__ATOMIC_RELEASE, "agent");
            asm volatile("s_waitcnt vmcnt(0)" ::: "memory");
            const unsigned og = xb_add(&bar[XB_TOP], 1u);
            const unsigned tg = og / nx;
            if (og + 1u == (tg + 1u) * nx) xb_add(&bar[XB_TOPGEN], 1u);
            else XB_SPIN(xb_ld(&bar[XB_TOPGEN]) == tg, bar);
            __builtin_amdgcn_fence(__ATOMIC_ACQUIRE, "agent");
            xb_add(&bar[XB_XGEN(b.x)], 1u);
            asm volatile("s_waitcnt vmcnt(0)" ::: "memory");
        } else {
            XB_SPIN(xb_ld(&bar[XB_XGEN(b.x)]) == gen, bar);
            __builtin_amdgcn_fence(__ATOMIC_ACQUIRE, "agent");
            asm volatile("s_waitcnt vmcnt(0)" ::: "memory");
        }
    }
    __syncthreads();
}

struct Frame {
    LAS unsigned char* lds;
    volatile LAS unsigned* MISC;
    gu32* ctl;
    int tid, lane, wave;
    int vcu, G;
    float* out; unsigned char* ws;
};
__device__ __forceinline__ float wave_sum(float v) {
#pragma unroll
    for (int o = 1; o < 64; o <<= 1) v += __shfl_xor(v, o);
    return v;
}
__device__ __forceinline__ float sigm_f(float x) { return __builtin_amdgcn_rcpf(1.0f + __builtin_amdgcn_exp2f(-x * LOG2E)); }
__device__ __forceinline__ float gelu_tanh(float x) { return x * sigm_f(1.5957691216057308f * (x + 0.044715f * x * x * x)); }
__device__ __forceinline__ unsigned short bf1(float f) { return (unsigned short)f2bf(f); }

__device__ __forceinline__ void transpose_item(const float* W, int K, int N, bf16* WT, int k0, int n0, int dst_row0, LAS float* scr, int lane) {
#pragma unroll 8
    for (int i = 0; i < 32; ++i) { const int kk = 2 * i + (lane >> 5); scr[kk * 33 + (lane & 31)] = W[(size_t)(k0 + kk) * N + n0 + (lane & 31)]; }
    LDS_WAIT(); asm volatile("" ::: "memory");
    const int c = lane & 7;
#pragma unroll
    for (int j = 0; j < 4; ++j) { const int n = (lane >> 3) + 8 * j; const LAS float* s = scr + (8 * c) * 33 + n;
        v4u o; o.x = pk2(s[0 * 33], s[1 * 33]); o.y = pk2(s[2 * 33], s[3 * 33]); o.z = pk2(s[4 * 33], s[5 * 33]); o.w = pk2(s[6 * 33], s[7 * 33]);
        *(GAS v4u*)(WT + (size_t)(dst_row0 + n) * K + k0 + 8 * c) = o; }
    LDS_WAIT(); asm volatile("" ::: "memory");
}
__device__ __forceinline__ void transpose_plain(const float* W, int K, int N, bf16* WT, int item, LAS float* scr, int lane) {
    const int nblk = N / 32, kb = item / nblk, nb = item % nblk; transpose_item(W, K, N, WT, 64 * kb, 32 * nb, 32 * nb, scr, lane);
}
__device__ __forceinline__ void transpose_swiglu(const float* W, bf16* WT, int item, LAS float* scr, int lane) {
    const int N = 2 * FF, nblk = N / 32, kb = item / nblk, nb = item % nblk, n0 = 32 * nb; const int up = n0 >= FF ? 1 : 0, j = n0 - up * FF;
    transpose_item(W, D, N, WT, 64 * kb, n0, 256 * (j / 128) + 128 * up + (j % 128), scr, lane);
}

__device__ __forceinline__ void rmsmod_row(const float* xrow, const float* gain, const float* shift, const float* scale, bf16* orow, int lane) {
    const GAS f32x4* xr = (const GAS f32x4*)xrow + lane;
    f32x4 v[4]; float s = 0.f;
#pragma unroll
    for (int j = 0; j < 4; ++j) { v[j] = xr[64 * j]; s += (v[j].x * v[j].x + v[j].y * v[j].y) + (v[j].z * v[j].z + v[j].w * v[j].w); }
    const float rs = 1.0f / sqrtf(wave_sum(s) * (1.f / D) + RMS_EPS);
    GAS unsigned long long* o8 = (GAS unsigned long long*)orow + lane;
#pragma unroll
    for (int j = 0; j < 4; ++j) { const int c = 4 * lane + 256 * j; const f32x4 g = *(const f32x4*)(gain + c), sc = *(const f32x4*)(scale + c), sh = *(const f32x4*)(shift + c);
        const f32x4 u = v[j] * rs * g * (sc + 1.0f) + sh;
        o8[64 * j] = (unsigned long long)pk2(u.x, u.y) | ((unsigned long long)pk2(u.z, u.w) << 32); }
}
__device__ __forceinline__ void norm_phase(Frame& F, const float* hp, const float* hs, const float* gain, int sh_off, int sc_off) {
    const int gw = F.vcu * NWAVES + F.wave, NGW = F.G * NWAVES; const float* mod = (const float*)(F.ws + WS_MOD); bf16* U = (bf16*)(F.ws + WS_U);
    for (int m = gw; m < M; m += NGW) { const float* mr = mod + (size_t)seq_of_row(m) * NMOD;
        rmsmod_row(m < NP ? hp + (size_t)m * D : hs + (size_t)(m - NP) * D, gain, mr + sh_off, mr + sc_off, U + (size_t)m * D, F.lane); }
}

template <int NK, bool ISNEW>
__device__ __forceinline__ void sattn_tile(const float* kbase, const float* vbase, int lane, float bias2, const LAS float* Qs, LAS float* Ws, float (&C)[8], float (&o)[8]) {
    const int kr = lane < NK ? lane : NK - 1;
    const f32x4* kp = (const f32x4*)(kbase + (size_t)kr * 512);
    f32x4 k[16];
#pragma unroll
    for (int i = 0; i < 16; ++i) k[i] = kp[i];
    float s[8];
#pragma unroll
    for (int q = 0; q < 8; ++q) s[q] = 0.f;
#pragma unroll
    for (int d4 = 0; d4 < 16; ++d4) {
#pragma unroll
        for (int q = 0; q < 8; ++q) { const f32x4 qv = *(const LAS f32x4*)(Qs + q * 64 + d4 * 4); s[q] += (k[d4].x * qv.x + k[d4].y * qv.y) + (k[d4].z * qv.z + k[d4].w * qv.w); }
        if (d4 & 1) __builtin_amdgcn_sched_barrier(0); }
    __builtin_amdgcn_sched_barrier(0);
    float v[NK];
#pragma unroll
    for (int kk = 0; kk < NK; ++kk) v[kk] = vbase[(size_t)kk * 512 + lane];
    __builtin_amdgcn_sched_barrier(0);
    float wq[8];
#pragma unroll
    for (int q = 0; q < 8; ++q) {
        const bool valid = ISNEW ? (lane < q) : true;
        const float z = __builtin_fminf(s[q] + bias2, 60.0f);
        const float E = valid ? __builtin_amdgcn_exp2f(z) : 0.f;
        float r = valid ? __builtin_amdgcn_rcpf(1.0f + E) : 1.0f;
#pragma unroll
        for (int off = 1; off < 64; off <<= 1) { const float y = __shfl_down(r, off); if (lane + off < 64) r *= y; }
        const float tot = __builtin_bit_cast(float, __builtin_amdgcn_readfirstlane(__builtin_bit_cast(int, r)));
        wq[q] = E * r * C[q]; C[q] *= tot;
    }
    *(LAS f32x4*)(Ws + lane * 8) = (f32x4){wq[0], wq[1], wq[2], wq[3]}; *(LAS f32x4*)(Ws + lane * 8 + 4) = (f32x4){wq[4], wq[5], wq[6], wq[7]};
    LDS_WAIT(); asm volatile("" ::: "memory");
#pragma unroll
    for (int kk = 0; kk < NK; ++kk) { const f32x4 w0 = *(const LAS f32x4*)(Ws + kk * 8), w1 = *(const LAS f32x4*)(Ws + kk * 8 + 4);
        o[0] += w0.x * v[kk]; o[1] += w0.y * v[kk]; o[2] += w0.z * v[kk]; o[3] += w0.w * v[kk]; o[4] += w1.x * v[kk]; o[5] += w1.y * v[kk]; o[6] += w1.z * v[kk]; o[7] += w1.w * v[kk];
        if ((kk & 7) == 7) __builtin_amdgcn_sched_barrier(0); }
    LDS_WAIT(); asm volatile("" ::: "memory");
}
__device__ __forceinline__ void sattn_unit(Frame& F, int b, int hg, const float* sb_bias, const float* cache_k, const float* cache_v, const int* ptab) {
    const int w = F.wave, lane = F.lane, h = hg * 4 + (w & 3), half = w >> 2;
    LAS float* Qs = (LAS float*)(F.lds + RING_OFF + w * 4096);
    LAS float* Ws = (LAS float*)(F.lds + RING_OFF + w * 4096 + 2048);
    LAS float* Oc = (LAS float*)(F.lds + RING_OFF + 32768);
    const int row0 = NP + b * ST;
    const bf16* QB = (const bf16*)(F.ws + WS_Q);
    { const int q = lane >> 3, d8 = (lane & 7) * 8; const v4u raw = *(const GAS v4u*)(QB + (size_t)(row0 + q) * HW + h * HD + d8);
      LAS float* dst = Qs + q * 64 + d8;
      *(LAS f32x4*)dst = (f32x4){__builtin_bit_cast(float, raw.x << 16), __builtin_bit_cast(float, raw.x & 0xffff0000u), __builtin_bit_cast(float, raw.y << 16), __builtin_bit_cast(float, raw.y & 0xffff0000u)};
      *(LAS f32x4*)(dst + 4) = (f32x4){__builtin_bit_cast(float, raw.z << 16), __builtin_bit_cast(float, raw.z & 0xffff0000u), __builtin_bit_cast(float, raw.w << 16), __builtin_bit_cast(float, raw.w & 0xffff0000u)}; }
    LDS_WAIT(); asm volatile("" ::: "memory");
    float C[8], o[8];
#pragma unroll
    for (int q = 0; q < 8; ++q) { C[q] = 1.0f; o[q] = 0.f; }
    const float bias2 = sb_bias[h] * LOG2E;
    if (half == 1) sattn_tile<8, true>(F.out + O_KS + (size_t)b * ST * 512 + h * HD, F.out + O_VS + (size_t)b * ST * 512 + h * HD, lane, bias2, Qs, Ws, C, o);
    for (int tt = 15; tt >= 0; --tt) {
        const int pos0 = 1024 * half + 64 * tt; const int page = __builtin_amdgcn_readfirstlane(ptab[b * NPAGES + (pos0 >> 7)]);
        const size_t base = ((size_t)page * PAGE + (pos0 & 127)) * 512 + h * HD;
        sattn_tile<64, false>(cache_k + base, cache_v + base, lane, bias2, Qs, Ws, C, o);
    }
    if (half == 0) {
#pragma unroll
        for (int q = 0; q < 8; ++q) Oc[((w & 3) * 8 + q) * 64 + lane] = o[q]; }
    LDS_WAIT(); __syncthreads();
    if (half == 1) { bf16* OA = (bf16*)(F.ws + WS_OA);
#pragma unroll
        for (int q = 0; q < 8; ++q) { const float r = o[q] + C[q] * Oc[((w & 3) * 8 + q) * 64 + lane]; OA[(size_t)(row0 + q) * HW + h * HD + lane] = bf1(r); } }
    LDS_WAIT(); __syncthreads();
}

constexpr int SSM_WBYTES = 13312, SSM_XPITCH = 136;
struct SsmLane { float ar, ai, lr, li, dt; };
struct SsmPtrs { const float *lre, *lim, *ldt, *bre, *bim, *cre, *cim, *dsk, *s0r, *s0i; };
__device__ __forceinline__ SsmLane ssm_lane(const SsmPtrs& P, int g, int p) {
    SsmLane L; L.lr = P.lre[g * 64 + p]; L.li = P.lim[g * 64 + p]; L.dt = expf(P.ldt[g]);
    const float mag = expf(L.lr * L.dt); float sn, cs; sincosf(L.li * L.dt, &sn, &cs); L.ar = mag * cs; L.ai = mag * sn; return L;
}
__device__ __forceinline__ void ssm_cfrag(const SsmPtrs& P, int g, int lane, pg8::bf16x8 (&cf)[4]) {
    const int h = lane & 15, kq = lane >> 4;
#pragma unroll
    for (int s = 0; s < 4; ++s) { const float* src = (s < 2 ? P.cre : P.cim) + (size_t)(g * 16 + h) * 64 + 32 * (s & 1) + 8 * kq; const float sg = s < 2 ? 1.f : -1.f;
        const f32x4 a = *(const f32x4*)src * sg, b = *(const f32x4*)(src + 4) * sg;
        v4u w; w.x = pk2(a.x, a.y); w.y = pk2(a.z, a.w); w.z = pk2(b.x, b.y); w.w = pk2(b.z, b.w); cf[s] = __builtin_bit_cast(pg8::bf16x8, w); }
}
__device__ __forceinline__ pg8::f32x4 ssm_cproj(const LAS unsigned short* X, int blk, int lane, const pg8::bf16x8 (&cf)[4]) {
    pg8::f32x4 acc = (pg8::f32x4){0.f, 0.f, 0.f, 0.f};
#pragma unroll
    for (int s = 0; s < 4; ++s) { const pg8::bf16x8 a = *(const LAS pg8::bf16x8*)(X + (blk * 16 + (lane & 15)) * SSM_XPITCH + 32 * s + 8 * (lane >> 4));
        acc = __builtin_amdgcn_mfma_f32_16x16x32_bf16(a, cf[s], acc, 0, 0, 0); }
    return acc;
}
template <bool SAMPLE>
__device__ __forceinline__ void ssm_scan_unit(Frame& F, const SsmPtrs& P, int b, int g, int c) {
    const int lane = F.lane, p = lane;
    LAS float* U = (LAS float*)(F.lds + RING_OFF + F.wave * SSM_WBYTES); LAS unsigned short* X = (LAS unsigned short*)(F.lds + RING_OFF + F.wave * SSM_WBYTES + 4096);
    const SsmLane L = ssm_lane(P, g, p);
    const float den = L.lr * L.lr + L.li * L.li, nr = L.ar - 1.0f, ni = L.ai; const float zr = (nr * L.lr + ni * L.li) / den, zi = (ni * L.lr - nr * L.li) / den;
    float bbr[16], bbi[16];
    { const float* br = P.bre + (size_t)(g * 64 + p) * 16; const float* bi = P.bim + (size_t)(g * 64 + p) * 16;
#pragma unroll
      for (int q4 = 0; q4 < 4; ++q4) { const f32x4 r = *(const f32x4*)(br + 4 * q4), i = *(const f32x4*)(bi + 4 * q4);
#pragma unroll
          for (int e = 0; e < 4; ++e) { bbr[4 * q4 + e] = zr * r[e] - zi * i[e]; bbi[4 * q4 + e] = zr * i[e] + zi * r[e]; } } }
    pg8::bf16x8 cf[4]; ssm_cfrag(P, g, lane, cf);
    const float dsk = P.dsk[g * 16 + (lane & 15)];
    const int tok0 = SAMPLE ? NP + b * ST : b * SEQ + c * SSM_T; constexpr int T = SAMPLE ? ST : SSM_T;
    const float* S = (const float*)(F.ws + WS_S);
    if (lane < T) { const f32x4* src = (const f32x4*)(S + (size_t)(tok0 + lane) * HW + g * 16);
#pragma unroll
        for (int q4 = 0; q4 < 4; ++q4) *(LAS f32x4*)(U + lane * 16 + 4 * q4) = src[q4]; }
    LDS_WAIT(); asm volatile("" ::: "memory");
    float xr = 0.f, xi = 0.f;
    if (SAMPLE) { xr = P.s0r[(size_t)(b * NGRP + g) * 64 + p]; xi = P.s0i[(size_t)(b * NGRP + g) * 64 + p]; }
    float* Y = (float*)(F.ws + WS_Y); bf16* ZG = (bf16*)(F.ws + WS_ZG);
#pragma unroll 1
    for (int sub = 0; sub < (SAMPLE ? 1 : 2); ++sub) {
#pragma unroll 4
        for (int tt = 0; tt < (SAMPLE ? ST : 32); ++tt) { const int t = sub * 32 + tt;
            float bur = 0.f, bui = 0.f;
#pragma unroll
            for (int q4 = 0; q4 < 4; ++q4) { const f32x4 u = *(const LAS f32x4*)(U + t * 16 + 4 * q4);
#pragma unroll
                for (int e = 0; e < 4; ++e) { bur += bbr[4 * q4 + e] * u[e]; bui += bbi[4 * q4 + e] * u[e]; } }
            const float nxr = L.ar * xr - L.ai * xi + bur, nxi = L.ar * xi + L.ai * xr + bui; xr = nxr; xi = nxi;
            X[tt * SSM_XPITCH + p] = bf1(xr); X[tt * SSM_XPITCH + 64 + p] = bf1(xi); }
        LDS_WAIT(); asm volatile("" ::: "memory");
#pragma unroll
        for (int blk = 0; blk < (SAMPLE ? 1 : 2); ++blk) { const pg8::f32x4 acc = ssm_cproj(X, blk, lane, cf);
#pragma unroll
            for (int r = 0; r < 4; ++r) { const int t = sub * 32 + blk * 16 + 4 * (lane >> 4) + r, h = lane & 15; const float y = acc[r] + dsk * U[t * 16 + h];
                if (SAMPLE) { if (t < ST) ZG[(size_t)(tok0 + t) * HW + g * 16 + h] = bf1(gelu_tanh(y)); }
                else Y[(size_t)(tok0 + t) * HW + g * 16 + h] = y; } }
        LDS_WAIT(); asm volatile("" ::: "memory");
    }
    if (SAMPLE) { F.out[O_SRS + (size_t)(b * NGRP + g) * 64 + p] = xr; F.out[O_SIS + (size_t)(b * NGRP + g) * 64 + p] = xi; }
    else { float2* E = (float2*)(F.ws + WS_END); E[((size_t)(b * SSM_NCH + c) * NGRP + g) * 64 + p] = make_float2(xr, xi); }
}
__device__ __forceinline__ void ssm_fix_unit(Frame& F, const SsmPtrs& P, int b, int g, int c) {
    const int lane = F.lane, p = lane;
    LAS unsigned short* X = (LAS unsigned short*)(F.lds + RING_OFF + F.wave * SSM_WBYTES + 4096);
    const SsmLane L = ssm_lane(P, g, p);
    const float magT = expf(L.lr * L.dt * (float)SSM_T); float snT, csT; sincosf(L.li * L.dt * (float)SSM_T, &snT, &csT); const float tr = magT * csT, ti = magT * snT;
    const float2* E = (const float2*)(F.ws + WS_END);
    float cr = 0.f, ci = 0.f;
    {
        const float2* Eb = E + ((size_t)(b * SSM_NCH) * NGRP + g) * 64 + p; constexpr size_t ES = (size_t)NGRP * 64;
        int cc = 0;
        for (; cc + 16 <= c; cc += 16) { float2 e[16];
#pragma unroll
            for (int i = 0; i < 16; ++i) e[i] = Eb[(size_t)(cc + i) * ES];
#pragma unroll
            for (int i = 0; i < 16; ++i) { const float nr = tr * cr - ti * ci + e[i].x, ni = tr * ci + ti * cr + e[i].y; cr = nr; ci = ni; } }
        for (; cc < c; ++cc) { const float2 e = Eb[(size_t)cc * ES]; const float nr = tr * cr - ti * ci + e.x, ni = tr * ci + ti * cr + e.y; cr = nr; ci = ni; }
    }
    if (c == SSM_NCH - 1) { const float2 e = E[((size_t)(b * SSM_NCH + c) * NGRP + g) * 64 + p];
        F.out[O_SRP + (size_t)(b * NGRP + g) * 64 + p] = tr * cr - ti * ci + e.x; F.out[O_SIP + (size_t)(b * NGRP + g) * 64 + p] = tr * ci + ti * cr + e.y; }
    pg8::bf16x8 cf[4]; ssm_cfrag(P, g, lane, cf);
    const int tok0 = b * SEQ + c * SSM_T;
    const float* Y = (const float*)(F.ws + WS_Y); bf16* ZG = (bf16*)(F.ws + WS_ZG);
    float zr = cr, zi = ci;
#pragma unroll 1
    for (int sub = 0; sub < 2; ++sub) {
        if (c > 0) {
#pragma unroll 4
            for (int tt = 0; tt < 32; ++tt) { const float nr = L.ar * zr - L.ai * zi, ni = L.ar * zi + L.ai * zr; zr = nr; zi = ni;
                X[tt * SSM_XPITCH + p] = bf1(zr); X[tt * SSM_XPITCH + 64 + p] = bf1(zi); }
            LDS_WAIT(); asm volatile("" ::: "memory");
        }
#pragma unroll
        for (int blk = 0; blk < 2; ++blk) { pg8::f32x4 acc = (pg8::f32x4){0.f, 0.f, 0.f, 0.f}; if (c > 0) acc = ssm_cproj(X, blk, lane, cf);
#pragma unroll
            for (int r = 0; r < 4; ++r) { const int t = sub * 32 + blk * 16 + 4 * (lane >> 4) + r, h = lane & 15; const size_t idx = (size_t)(tok0 + t) * HW + g * 16 + h;
                ZG[idx] = bf1(gelu_tanh(Y[idx] + acc[r])); } }
        LDS_WAIT(); asm volatile("" ::: "memory");
    }
}


constexpr int SG_PITCH = 144, SG_TILE = 64 * SG_PITCH, SG_BUF = 4 * SG_TILE;
struct SgRegs { v4u a0, a1, b0, b1; };
__device__ __forceinline__ void sg_load(SgRegs& r, const bf16* ap, const bf16* bp) { r.a0 = *(const GAS v4u*)ap; r.a1 = *(const GAS v4u*)(ap + 64); r.b0 = *(const GAS v4u*)bp; r.b1 = *(const GAS v4u*)(bp + 64); }
__device__ __forceinline__ void sg_store(const SgRegs& r, LAS unsigned char* buf, int wofs) {
    *(LAS v4u*)(buf + wofs) = r.a0; *(LAS v4u*)(buf + SG_TILE + wofs) = r.a1; *(LAS v4u*)(buf + 2 * SG_TILE + wofs) = r.b0; *(LAS v4u*)(buf + 3 * SG_TILE + wofs) = r.b1; }
__device__ __forceinline__ void sg_compute(LAS unsigned char* buf, int aofs, int bofs, pg8::f32x4 (&acc)[2]) {
#pragma unroll
    for (int t = 0; t < 2; ++t)
#pragma unroll
        for (int s2 = 0; s2 < 2; ++s2) { const pg8::bf16x8 a = *(const LAS pg8::bf16x8*)(buf + t * SG_TILE + aofs + 64 * s2), b0 = *(const LAS pg8::bf16x8*)(buf + (2 + t) * SG_TILE + bofs + 64 * s2), b1 = *(const LAS pg8::bf16x8*)(buf + (2 + t) * SG_TILE + bofs + 16 * SG_PITCH + 64 * s2);
            acc[0] = __builtin_amdgcn_mfma_f32_16x16x32_bf16(b0, a, acc[0], 0, 0, 0); acc[1] = __builtin_amdgcn_mfma_f32_16x16x32_bf16(b1, a, acc[1], 0, 0, 0); }
}
__device__ __forceinline__ void sgemm_core(LAS unsigned char* lds, const bf16* Ag  , const bf16* Bg  , int K, int tid, int wr, int wc, int fr, int fq, pg8::f32x4 (&acc)[2]) {
    const int lr = tid >> 3, lk = (tid & 7) * 8;
    const bf16* ap = Ag + (size_t)lr * K + lk; const bf16* bp = Bg + (size_t)lr * K + lk;
    const int wofs = lr * SG_PITCH + lk * 2;
    const int aofs = (16 * wr + fr) * SG_PITCH + 16 * fq, bofs = (32 * wc + fr) * SG_PITCH + 16 * fq;
    const int ns = K / 128;
    SgRegs r0, r1; sg_load(r0, ap, bp); sg_load(r1, ap + 128, bp + 128);
    sg_store(r0, lds, wofs);
    LDS_WAIT(); __syncthreads();
#pragma unroll 1
    for (int st = 0; st < ns; st += 2) {
        if (st + 2 < ns) sg_load(r0, ap + (size_t)(st + 2) * 128, bp + (size_t)(st + 2) * 128);
        sg_compute(lds, aofs, bofs, acc);
        sg_store(r1, lds + SG_BUF, wofs);
        LDS_WAIT(); __syncthreads();
        if (st + 3 < ns) sg_load(r1, ap + (size_t)(st + 3) * 128, bp + (size_t)(st + 3) * 128);
        sg_compute(lds + SG_BUF, aofs, bofs, acc);
        if (st + 2 < ns) sg_store(r0, lds, wofs);
        LDS_WAIT(); __syncthreads();
    }
}
__device__ __forceinline__ void dg_glds16(const void* gsrc, unsigned lds_dst) { unsigned keep;
    asm volatile("s_mov_b32 %0, m0\n\ts_mov_b32 m0, %2\n\ts_nop 0\n\tglobal_load_lds_dwordx4 %1, off\n\ts_mov_b32 m0, %0" : "=&s"(keep) : "v"(gsrc), "s"(lds_dst) : "memory"); }
template <int BROWS> struct DgGeom { static constexpr int A_BYTES = 8192, B_BYTES = BROWS * 128, STAGE = A_BYTES + B_BYTES, NI = 1 + BROWS / 64; };
template <int BROWS, class Src>
__device__ __forceinline__ void dgemm_core(LAS unsigned char* lds, const Src& S, int ntile, int w, int wr, int wc, int fr, int fq, pg8::f32x4 (&acc)[BROWS / 32]) {
    typedef DgGeom<BROWS> G; constexpr int NB = 4, CW = BROWS / 2;
    const unsigned lds0 = (unsigned)(uintptr_t)lds;
#define DG_ISSUE(t_) do { const int tt_ = (t_) < ntile ? (t_) : ntile - 1; const unsigned sb_ = lds0 + (unsigned)(((t_) & (NB - 1)) * G::STAGE); \
        dg_glds16(S.a(tt_), (unsigned)__builtin_amdgcn_readfirstlane(sb_ + w * 1024)); dg_glds16(S.b(tt_, 0), (unsigned)__builtin_amdgcn_readfirstlane(sb_ + G::A_BYTES + w * 1024)); \
        if (BROWS == 128) dg_glds16(S.b(tt_, 1), (unsigned)__builtin_amdgcn_readfirstlane(sb_ + G::A_BYTES + 8192 + w * 1024)); } while (0)
    DG_ISSUE(0); DG_ISSUE(1); DG_ISSUE(2);
    const int arow = 16 * wr + fr, aswz = (arow >> 1) & 7;
    int brow[BROWS / 32], bswz[BROWS / 32];
#pragma unroll
    for (int nb = 0; nb < BROWS / 32; ++nb) { brow[nb] = CW * wc + 16 * nb + fr; bswz[nb] = (brow[nb] >> 1) & 7; }
#pragma unroll 1
    for (int i = 0; i < ntile; ++i) {
        if (BROWS == 128) asm volatile("s_waitcnt vmcnt(6)\n\ts_barrier" ::: "memory"); else asm volatile("s_waitcnt vmcnt(4)\n\ts_barrier" ::: "memory");
        DG_ISSUE(i + 3);
        LAS unsigned char* sb = lds + (i & (NB - 1)) * G::STAGE;
#pragma unroll
        for (int s2 = 0; s2 < 2; ++s2) { const pg8::bf16x8 a = *(const LAS pg8::bf16x8*)(sb + arow * 128 + (((4 * s2 + fq) ^ aswz) << 4));
#pragma unroll
            for (int nb = 0; nb < BROWS / 32; ++nb) { const pg8::bf16x8 b = *(const LAS pg8::bf16x8*)(sb + G::A_BYTES + brow[nb] * 128 + (((4 * s2 + fq) ^ bswz[nb]) << 4)); acc[nb] = __builtin_amdgcn_mfma_f32_16x16x32_bf16(b, a, acc[nb], 0, 0, 0); } }
    }
    asm volatile("s_waitcnt vmcnt(0) lgkmcnt(0)\n\ts_barrier" ::: "memory");
#undef DG_ISSUE
}
struct DgLinear { const bf16* ap; const bf16* bp; size_t bhalf;
    __device__ __forceinline__ const void* a(int t) const { return ap + 64 * t; }
    __device__ __forceinline__ const void* b(int t, int half) const { return bp + 64 * t + (half ? bhalf : 0); } };
__device__ __forceinline__ DgLinear dg_linear(const bf16* Ag, int lda, const bf16* Bg, int ldb, int w, int lane) {
    const int row = 8 * w + (lane >> 3), ch = (lane & 7) ^ ((row >> 1) & 7); DgLinear L; L.ap = Ag + (size_t)row * lda + ch * 8; L.bp = Bg + (size_t)row * ldb + ch * 8; L.bhalf = (size_t)64 * ldb; return L; }
template <class Src>
__device__ __forceinline__ void dgemm_core128(LAS unsigned char* lds, const Src& S, int ntile, int w, int wr, int wc, int fr, int fq, pg8::f32x4 (&acc)[2][4]) {
    constexpr int NB = 4, STAGE = 32768, AB = 16384;
    const unsigned lds0 = (unsigned)(uintptr_t)lds;
#define DG_ISSUE(t_) do { const int tt_ = (t_) < ntile ? (t_) : ntile - 1; const unsigned sb_ = lds0 + (unsigned)(((t_) & (NB - 1)) * STAGE); \
        dg_glds16(S.a(tt_, 0), (unsigned)__builtin_amdgcn_readfirstlane(sb_ + w * 1024)); dg_glds16(S.a(tt_, 1), (unsigned)__builtin_amdgcn_readfirstlane(sb_ + 8192 + w * 1024)); \
        dg_glds16(S.b(tt_, 0), (unsigned)__builtin_amdgcn_readfirstlane(sb_ + AB + w * 1024)); dg_glds16(S.b(tt_, 1), (unsigned)__builtin_amdgcn_readfirstlane(sb_ + AB + 8192 + w * 1024)); } while (0)
    DG_ISSUE(0); DG_ISSUE(1); DG_ISSUE(2);
    int arow[2], aswz[2], brow[4], bswz[4];
#pragma unroll
    for (int rb = 0; rb < 2; ++rb) { arow[rb] = 32 * wr + 16 * rb + fr; aswz[rb] = (arow[rb] >> 1) & 7; }
#pragma unroll
    for (int nb = 0; nb < 4; ++nb) { brow[nb] = 64 * wc + 16 * nb + fr; bswz[nb] = (brow[nb] >> 1) & 7; }
#pragma unroll 1
    for (int i = 0; i < ntile; ++i) {
        asm volatile("s_waitcnt vmcnt(8)\n\ts_barrier" ::: "memory");
        DG_ISSUE(i + 3);
        LAS unsigned char* sb = lds + (i & (NB - 1)) * STAGE;
#pragma unroll
        for (int s2 = 0; s2 < 2; ++s2) { pg8::bf16x8 a[2], b[4];
#pragma unroll
            for (int rb = 0; rb < 2; ++rb) a[rb] = *(const LAS pg8::bf16x8*)(sb + arow[rb] * 128 + (((4 * s2 + fq) ^ aswz[rb]) << 4));
#pragma unroll
            for (int nb = 0; nb < 4; ++nb) b[nb] = *(const LAS pg8::bf16x8*)(sb + AB + brow[nb] * 128 + (((4 * s2 + fq) ^ bswz[nb]) << 4));
#pragma unroll
            for (int rb = 0; rb < 2; ++rb)
#pragma unroll
                for (int nb = 0; nb < 4; ++nb) acc[rb][nb] = __builtin_amdgcn_mfma_f32_16x16x32_bf16(b[nb], a[rb], acc[rb][nb], 0, 0, 0); }
    }
    asm volatile("s_waitcnt vmcnt(0) lgkmcnt(0)\n\ts_barrier" ::: "memory");
#undef DG_ISSUE
}
struct DgLinear128 { const bf16* ap; const bf16* bp; size_t ahalf, bhalf;
    __device__ __forceinline__ const void* a(int t, int half) const { return ap + 64 * t + (half ? ahalf : 0); }
    __device__ __forceinline__ const void* b(int t, int half) const { return bp + 64 * t + (half ? bhalf : 0); } };
template <class Epi>
__device__ __forceinline__ void sgemm128_phase(Frame& F, const bf16* A1, const bf16* B1, int K1, int N, const Epi& E) {
    const int nunits = (NS / 128) * (N / 128);
    const int w = F.wave, lane = F.lane, wr = w >> 1, wc = w & 1, fr = lane & 15, fq = lane >> 4;
    const int row = 8 * w + (lane >> 3), ch = (lane & 7) ^ ((row >> 1) & 7);
    for (int u = F.vcu; u < nunits; u += F.G) {
        const int rt = u % (NS / 128), ct = u / (NS / 128);
        DgLinear128 L; L.ap = A1 + (size_t)(NP + rt * 128 + row) * K1 + ch * 8; L.bp = B1 + (size_t)(ct * 128 + row) * K1 + ch * 8; L.ahalf = (size_t)64 * K1; L.bhalf = (size_t)64 * K1;
        pg8::f32x4 acc[2][4];
#pragma unroll
        for (int rb = 0; rb < 2; ++rb)
#pragma unroll
            for (int nb = 0; nb < 4; ++nb) acc[rb][nb] = (pg8::f32x4){0.f, 0.f, 0.f, 0.f};
        dgemm_core128<DgLinear128>(F.lds + RING_OFF, L, K1 / 64, w, wr, wc, fr, fq, acc);
#pragma unroll
        for (int rb = 0; rb < 2; ++rb)
#pragma unroll
            for (int nb = 0; nb < 4; ++nb) E(acc[rb][nb], acc[rb][nb], NP + rt * 128 + 32 * wr + 16 * rb + fr, ct * 128 + 64 * wc + 16 * nb + 4 * fq);
    }
}
struct SEpiResid {
    const float* base; float* out; const float* mod; int goff; float scale;
    __device__ __forceinline__ void operator()(const pg8::f32x4& v, const pg8::f32x4&, int row, int col) const {
        const size_t off = (size_t)(row - NP) * D + col; const pg8::f32x4 b = *(const pg8::f32x4*)(base + off), g = *(const pg8::f32x4*)(mod + (size_t)seq_of_row(row) * NMOD + goff + col);
        *(pg8::f32x4*)(out + off) = b + (g * scale) * v; }
};
struct SEpiInproj {
    bf16* Q; float* S; bf16* GA; bf16* GB; float* dout;
    __device__ __forceinline__ void operator()(const pg8::f32x4& v, const pg8::f32x4&, int row, int col) const {
        if (col < 512) { const pg8::f32x4 a = v * QSCALE; *(unsigned long long*)(Q + (size_t)row * HW + col) = (unsigned long long)pk2(a[0], a[1]) | ((unsigned long long)pk2(a[2], a[3]) << 32); }
        else if (col < 1536) { const bool isk = col < 1024; *(pg8::f32x4*)(dout + (isk ? O_KS : O_VS) + (size_t)(row - NP) * HW + (col - (isk ? 512 : 1024))) = v; }
        else if (col < 2048) { *(pg8::f32x4*)(S + (size_t)row * HW + (col - 1536)) = v; }
        else { const bool isa = col < 3072; bf16* o = (isa ? GA : GB) + (size_t)row * D + (col - (isa ? 2048 : 3072));
            *(unsigned long long*)o = (unsigned long long)pk2(sigm_f(v[0]), sigm_f(v[1])) | ((unsigned long long)pk2(sigm_f(v[2]), sigm_f(v[3])) << 32); }
    }
};
struct SEpiBranch {
    const bf16* GA; const bf16* GB; bf16* MRG;
    __device__ __forceinline__ void operator()(const pg8::f32x4& va, const pg8::f32x4& vb, int row, int col) const {
        const size_t off = (size_t)row * D + col; const unsigned long long ga = *(const unsigned long long*)(GA + off), gb = *(const unsigned long long*)(GB + off);
        const unsigned a0 = (unsigned)ga, a1 = (unsigned)(ga >> 32), b0 = (unsigned)gb, b1 = (unsigned)(gb >> 32);
        const float m0 = pg8::bf_lo(a0) * va[0] + pg8::bf_lo(b0) * vb[0], m1 = pg8::bf_hi(a0) * va[1] + pg8::bf_hi(b0) * vb[1];
        const float m2 = pg8::bf_lo(a1) * va[2] + pg8::bf_lo(b1) * vb[2], m3 = pg8::bf_hi(a1) * va[3] + pg8::bf_hi(b1) * vb[3];
        *(unsigned long long*)(MRG + off) = (unsigned long long)pk2(m0, m1) | ((unsigned long long)pk2(m2, m3) << 32); }
};
template <class Epi, bool DUAL>
__device__ __forceinline__ void sgemm_phase(Frame& F, const bf16* A1, const bf16* B1, int K1, const bf16* A2, const bf16* B2, int K2, int N, const Epi& E) {
    const int ncol = N / 64, nunits = (NS / 64) * ncol;
    const int w = F.wave, lane = F.lane, wr = w >> 1, wc = w & 1, fr = lane & 15, fq = lane >> 4;
    for (int u = F.vcu; u < nunits; u += F.G) {
        const int rt = u % (NS / 64), ct = u / (NS / 64);
        const int rowa = NP + rt * 64 + wr * 16 + fr, colb = ct * 64 + wc * 32;
        pg8::f32x4 acc[2], acc2[2];
#pragma unroll
        for (int i = 0; i < 2; ++i) { acc[i] = (pg8::f32x4){0.f, 0.f, 0.f, 0.f}; acc2[i] = (pg8::f32x4){0.f, 0.f, 0.f, 0.f}; }
        { const DgLinear L = dg_linear(A1 + (size_t)(NP + rt * 64) * K1, K1, B1 + (size_t)(ct * 64) * K1, K1, w, lane); dgemm_core<64, DgLinear>(F.lds + RING_OFF, L, K1 / 64, w, wr, wc, fr, fq, acc); }
        if (DUAL) { const DgLinear L = dg_linear(A2 + (size_t)(NP + rt * 64) * K2, K2, B2 + (size_t)(ct * 64) * K2, K2, w, lane); dgemm_core<64, DgLinear>(F.lds + RING_OFF, L, K2 / 64, w, wr, wc, fr, fq, acc2); }
#pragma unroll
        for (int nb = 0; nb < 2; ++nb) E(acc[nb], acc2[nb], rowa, colb + 16 * nb + 4 * fq);
    }
}


struct SsmTab { bf16* KT; bf16* ET; bf16* FT; };
__device__ __forceinline__ void ssm_build_tables(Frame& F, const SsmPtrs& P, const SsmTab& T, int g, int part) {
    typedef float f2 __attribute__((ext_vector_type(2)));
    LAS f2* pw = (LAS f2*)(F.lds + RING_OFF);
    LAS f2* Bb = (LAS f2*)(F.lds + RING_OFF + 65 * 64 * 8);
    LAS f2* Cc = Bb + 64 * 16;
    const int tid = F.tid; const float dt = expf(P.ldt[g]);
    if (tid < 64) { const int p = tid; const float lr = P.lre[g * 64 + p], li = P.lim[g * 64 + p]; const float mag = expf(lr * dt); float sn, cs; sincosf(li * dt, &sn, &cs); const float ar = mag * cs, ai = mag * sn;
        float wr = 1.0f, wi = 0.0f;
        for (int tau = 0; tau < 65; ++tau) { pw[tau * 64 + p] = (f2){wr, wi}; const float nr = wr * ar - wi * ai, ni = wr * ai + wi * ar; wr = nr; wi = ni; } }
    for (int idx = tid; idx < 64 * 16; idx += NWAVES * 64) { const int p = idx >> 4, h = idx & 15; const float lr = P.lre[g * 64 + p], li = P.lim[g * 64 + p];
        const float mag = expf(lr * dt); float sn, cs; sincosf(li * dt, &sn, &cs); const float ar = mag * cs, ai = mag * sn;
        const float den = lr * lr + li * li, nr = ar - 1.0f, ni = ai, zr = (nr * lr + ni * li) / den, zi = (ni * lr - nr * li) / den;
        const float br = P.bre[(size_t)(g * 64 + p) * 16 + h], bi = P.bim[(size_t)(g * 64 + p) * 16 + h];
        Bb[idx] = (f2){zr * br - zi * bi, zr * bi + zi * br};
        Cc[h * 64 + p] = (f2){P.cre[(size_t)(g * 16 + h) * 64 + p], P.cim[(size_t)(g * 16 + h) * 64 + p]}; }
    LDS_WAIT(); __syncthreads();
    if (part < 4) {
        const int h = (tid >> 4) & 15, hp = tid & 15, tau0 = 16 * part + (tid >> 8); float s[8];
#pragma unroll
        for (int j = 0; j < 8; ++j) s[j] = 0.f;
#pragma unroll 2
        for (int p = 0; p < 64; ++p) { const f2 b = Bb[p * 16 + hp], c = Cc[h * 64 + p]; const float cbr = c.x * b.x - c.y * b.y, cbi = c.x * b.y + c.y * b.x;
#pragma unroll
            for (int j = 0; j < 8; ++j) { const f2 w = pw[(tau0 + 2 * j) * 64 + p]; s[j] += cbr * w.x - cbi * w.y; } }
#pragma unroll
        for (int j = 0; j < 8; ++j) { const int tau = tau0 + 2 * j; float v = s[j]; if (tau == 0 && h == hp) v += P.dsk[g * 16 + h];
            T.KT[(size_t)g * 16384 + (size_t)tau * 256 + h * 16 + hp] = bf1(v); }
    } else if (part < 6) {
        for (int e8 = tid; e8 < 64 * 128; e8 += NWAVES * 64) { const int n = (part - 4) * 64 + (e8 >> 7), kk0 = (e8 & 127) * 8, ri = n >> 6, p = n & 63, k = kk0 >> 4, h0 = kk0 & 15; const f2 w = pw[(63 - k) * 64 + p]; float v[8];
#pragma unroll
            for (int i = 0; i < 8; ++i) { const f2 b = Bb[p * 16 + h0 + i]; v[i] = ri ? (w.x * b.y + w.y * b.x) : (w.x * b.x - w.y * b.y); }
            v4u o; o.x = pk2(v[0], v[1]); o.y = pk2(v[2], v[3]); o.z = pk2(v[4], v[5]); o.w = pk2(v[6], v[7]);
            *(GAS v4u*)(T.ET + ((size_t)g * 128 + n) * 1024 + kk0) = o; }
    } else {
        for (int e8 = tid; e8 < 512 * 16; e8 += NWAVES * 64) { const int row = (part - 6) * 512 + (e8 >> 4), c0 = (e8 & 15) * 8, t = row >> 4, h = row & 15, ri = c0 >> 6, p0 = c0 & 63; float v[8];
#pragma unroll
            for (int i = 0; i < 8; ++i) { const f2 c = Cc[h * 64 + p0 + i], w = pw[(t + 1) * 64 + p0 + i]; v[i] = ri ? -(c.x * w.y + c.y * w.x) : (c.x * w.x - c.y * w.y); }
            v4u o; o.x = pk2(v[0], v[1]); o.y = pk2(v[2], v[3]); o.z = pk2(v[4], v[5]); o.w = pk2(v[6], v[7]);
            *(GAS v4u*)(T.FT + ((size_t)g * 1024 + row) * 128 + c0) = o; }
    }
    LDS_WAIT(); __syncthreads();
}
__device__ __forceinline__ void ssm_stage1_unit(Frame& F, const SsmPtrs& P, const SsmTab& T, const bf16* AU, bf16* AC, int g, int b) {
    const int w = F.wave, lane = F.lane, wr = w >> 1, wc = w & 1, fr = lane & 15, fq = lane >> 4;
    LAS float* XE = (LAS float*)(F.lds + RING_OFF + 65536);
    const bf16* Ag = AU + (size_t)((g * 4 + b) * 64) * 1024;
#pragma unroll 1
    for (int ct = 0; ct < 2; ++ct) {
        pg8::f32x4 acc[2];
#pragma unroll
        for (int i = 0; i < 2; ++i) acc[i] = (pg8::f32x4){0.f, 0.f, 0.f, 0.f};
        { const DgLinear L = dg_linear(Ag, 1024, T.ET + ((size_t)g * 128 + ct * 64) * 1024, 1024, w, lane); dgemm_core<64, DgLinear>(F.lds + RING_OFF, L, 16, w, wr, wc, fr, fq, acc); }
#pragma unroll
        for (int nb = 0; nb < 2; ++nb) *(LAS pg8::f32x4*)(XE + (16 * wr + fr) * 128 + ct * 64 + 32 * wc + 16 * nb + 4 * fq) = acc[nb];
    }
    LDS_WAIT(); __syncthreads();
    if (w == 0) { const int p = lane; const float lr = P.lre[g * 64 + p], li = P.lim[g * 64 + p], dt = expf(P.ldt[g]);
        const float magT = expf(lr * dt * (float)SSM_T); float snT, csT; sincosf(li * dt * (float)SSM_T, &snT, &csT); const float tr = magT * csT, ti = magT * snT;
        float cr = 0.f, ci = 0.f; bf16* ac = AC + (size_t)((g * 4 + b) * 64) * 128;
#pragma unroll 4
        for (int c = 0; c < SSM_NCH; ++c) { ac[c * 128 + p] = bf1(cr); ac[c * 128 + 64 + p] = bf1(ci);
            const float xr = XE[c * 128 + p], xi = XE[c * 128 + 64 + p]; const float nr = tr * cr - ti * ci + xr, ni = tr * ci + ti * cr + xi; cr = nr; ci = ni; }
        F.out[O_SRP + (size_t)(b * NGRP + g) * 64 + p] = cr; F.out[O_SIP + (size_t)(b * NGRP + g) * 64 + p] = ci; }
    LDS_WAIT(); __syncthreads();
}
struct S2Src {
    const bf16* au; const bf16* ac; const bf16* kt0; const bf16* kt1; const bf16* ft0; const bf16* ft1; const bf16* zero; int nu, t0, kq;
    __device__ __forceinline__ const void* a(int t) const { return t < nu ? au + 64 * t : ac + 64 * (t - nu); }
    __device__ __forceinline__ const void* b(int t, int half) const {
        if (t < nu) { const int lag = t0 + 4 * half - (4 * t + kq); return lag >= 0 ? (half ? kt1 : kt0) + lag * 256 : zero; }
        return (half ? ft1 : ft0) + 64 * (t - nu); }
};
__device__ __forceinline__ void ssm_stage2_unit(Frame& F, const SsmTab& T, const bf16* AU, const bf16* AC, bf16* ZG, int g, int b, int j2) {
    const int w = F.wave, lane = F.lane, wr = w >> 1, wc = w & 1, fr = lane & 15, fq = lane >> 4;
    const int row = 8 * w + (lane >> 3), ch = (lane & 7) ^ ((row >> 1) & 7);
    S2Src S; S.nu = 2 * j2 + 2; S.t0 = 8 * j2 + (row >> 4); S.kq = ch >> 1; S.zero = (const bf16*)(F.ws + WS_ZERO);
    S.au = AU + ((size_t)((g * 4 + b) * 64) + row) * 1024 + ch * 8; S.ac = AC + ((size_t)((g * 4 + b) * 64) + row) * 128 + ch * 8;
    S.kt0 = T.KT + (size_t)g * 16384 + (row & 15) * 16 + (ch & 1) * 8; S.kt1 = S.kt0;
    S.ft0 = T.FT + ((size_t)g * 1024 + (size_t)S.t0 * 16 + (row & 15)) * 128 + ch * 8; S.ft1 = S.ft0 + (size_t)4 * 16 * 128;
    pg8::f32x4 acc[4];
#pragma unroll
    for (int i = 0; i < 4; ++i) acc[i] = (pg8::f32x4){0.f, 0.f, 0.f, 0.f};
    dgemm_core<128, S2Src>(F.lds + RING_OFF, S, S.nu + 2, w, wr, wc, fr, fq, acc);
    const int c = 16 * wr + fr;
#pragma unroll
    for (int nb = 0; nb < 4; ++nb) { const int col = 64 * wc + 16 * nb + 4 * fq, tt = col >> 4, h = col & 15; const size_t tok = (size_t)b * SEQ + c * SSM_T + 8 * j2 + tt;
        *(unsigned long long*)(ZG + tok * HW + g * 16 + h) = (unsigned long long)pk2(gelu_tanh(acc[nb][0]), gelu_tanh(acc[nb][1])) | ((unsigned long long)pk2(gelu_tanh(acc[nb][2]), gelu_tanh(acc[nb][3])) << 32); }
}

struct Args { const float* in[34]; float* out; unsigned char* ws; int ph_lo, ph_hi, sub, pad; };
__global__ void __launch_bounds__(NWAVES * 64, 2) sbs5_fwd(Args args) {
    extern __shared__ __attribute__((aligned(16))) unsigned char lds[];
    Frame F;
    F.lds = (LAS unsigned char*)lds;
    F.MISC = (volatile LAS unsigned*)(F.lds + MISC_OFF);
    F.tid = threadIdx.x; F.lane = F.tid & 63; F.wave = __builtin_amdgcn_readfirstlane(F.tid >> 6);
    F.G = gridDim.x; { const int bx = blockIdx.x; F.vcu = (F.G % 8 == 0) ? (bx % 8) * (F.G / 8) + bx / 8 : bx; }
    F.ws = args.ws; F.out = args.out; F.ctl = (gu32*)(args.ws + WS_CTL);
    for (int u = F.tid; u < (LDS_BYTES - LDSCTL_OFF) / 4; u += NWAVES * 64) ((LAS unsigned*)(F.lds + LDSCTL_OFF))[u] = 0u;
    __syncthreads();
    XcdBarrier bar; bar.bar = (unsigned*)(F.ctl + CW_BAR); bar.x = 0; bar.st = nullptr;
    if (!MK_PER_PHASE) bar = xcd_barrier_post((unsigned*)(F.ctl + CW_BAR), F.MISC + 8);
    const int lo = args.ph_lo, hi = args.ph_hi;
#ifndef PH_MASK
#define PH_MASK 0xFFFF
#endif
#ifndef REP_MASK
#define REP_MASK 0
#endif
#define REPEAT(bit) for (int rep_ = 0; rep_ < ((((REP_MASK) >> (bit)) & 1) + 1); ++rep_)
#define IN(k) ((((PH_MASK) >> (k)) & 1) && lo <= (k) && (k) < hi)
#define SEAM(k) do { if (IN(k) && IN((k) + 1)) xcd_barrier(bar); } while (0)
    unsigned char* ws = F.ws;
    const float* MOD = (const float*)(ws + WS_MOD);
    bf16* U = (bf16*)(ws + WS_U); bf16* HID = (bf16*)(ws + WS_HID); float* H = (float*)(ws + WS_H);
    const int gw = F.vcu * NWAVES + F.wave, NGW = F.G * NWAVES;
    const SsmTab ST_{(bf16*)(args.ws + WS_KT), (bf16*)(args.ws + WS_ET), (bf16*)(args.ws + WS_FT)};
    const SsmPtrs SP{args.in[17], args.in[18], args.in[19], args.in[20], args.in[21], args.in[22], args.in[23], args.in[24], args.in[6], args.in[7]};

    if (IN(0)) REPEAT(0) {
        LAS float* scr = (LAS float*)(F.lds + RING_OFF + F.wave * 16384);
        for (int it = gw; it < (D / 64) * (NMOD / 32); it += NGW) transpose_plain(args.in[9], D, NMOD, (bf16*)(ws + WS_ADA_T), it, scr, F.lane);
        for (int r = gw; r < 256; r += NGW) { bf16* o = (bf16*)(ws + WS_SC) + (size_t)r * D;
            const float* c = r < PB ? args.in[2] + (size_t)r * D : args.in[3] + (size_t)(r - PB) * D;
#pragma unroll
            for (int j = 0; j < 4; ++j) { const int col = 4 * F.lane + 256 * j; f32x4 v = (f32x4){0.f, 0.f, 0.f, 0.f};
                if (r < NSEQ) { v = *(const f32x4*)(c + col); v.x *= sigm_f(v.x); v.y *= sigm_f(v.y); v.z *= sigm_f(v.z); v.w *= sigm_f(v.w); }
                *(unsigned long long*)(o + col) = (unsigned long long)pk2(v.x, v.y) | ((unsigned long long)pk2(v.z, v.w) << 32); } }
    }
    SEAM(0);
    if (IN(1)) REPEAT(1) {
        constexpr int NMODWG = NMOD / 256;
        if ((int)blockIdx.x < NMODWG) {
            pg8::Gemm g{(const bf16*)(ws + WS_SC), (const bf16*)(ws + WS_ADA_T), 256, NMOD, D, nullptr, nullptr}; pg8::StaticOrder S; S.init(256, NMOD, NMODWG, (int)blockIdx.x);
            pg8::EpiMod E{(float*)(ws + WS_MOD), args.in[10]};
            pg8::gemm_phase<pg8::EpiMod, pg8::StaticOrder, true, true>(F.lds + RING_OFF, g, S, E);
        } else {
            for (int tu = (int)blockIdx.x - NMODWG; tu < NGRP * 8; tu += F.G - NMODWG) ssm_build_tables(F, SP, ST_, tu >> 3, tu & 7);
            LAS float* scr = (LAS float*)(F.lds + RING_OFF + F.wave * 16384);
            const int tw = ((int)blockIdx.x - NMODWG) * NWAVES + F.wave, NTW = (F.G - NMODWG) * NWAVES;
            constexpr int I_FIN = (D / 64) * (2 * FF / 32), I_FOUT = (FF / 64) * (D / 32), I_IN = (D / 64) * (NIN / 32), I_GLU = (HW / 64) * (HW / 32), I_BR = (HW / 64) * (D / 32), I_OUT = (D / 64) * (D / 32);
            constexpr int NITEMS = 2 * I_FIN + 2 * I_FOUT + I_IN + I_GLU + 2 * I_BR + I_OUT;
            for (int it = tw; it < NITEMS; it += NTW) {
                int r = it;
                if (r < I_FIN) { transpose_swiglu(args.in[12], (bf16*)(ws + WS_W1IN_T), r, scr, F.lane); continue; } r -= I_FIN;
                if (r < I_FOUT) { transpose_plain(args.in[13], FF, D, (bf16*)(ws + WS_W1OUT_T), r, scr, F.lane); continue; } r -= I_FOUT;
                if (r < I_IN) { transpose_plain(args.in[15], D, NIN, (bf16*)(ws + WS_WIN_T), r, scr, F.lane); continue; } r -= I_IN;
                if (r < I_GLU) { transpose_plain(args.in[25], HW, HW, (bf16*)(ws + WS_GLU_T), r, scr, F.lane); continue; } r -= I_GLU;
                if (r < I_BR) { transpose_plain(args.in[27], HW, D, (bf16*)(ws + WS_WA_T), r, scr, F.lane); continue; } r -= I_BR;
                if (r < I_BR) { transpose_plain(args.in[28], HW, D, (bf16*)(ws + WS_WB_T), r, scr, F.lane); continue; } r -= I_BR;
                if (r < I_OUT) { transpose_plain(args.in[29], D, D, (bf16*)(ws + WS_WOUT_T), r, scr, F.lane); continue; } r -= I_OUT;
                if (r < I_FIN) { transpose_swiglu(args.in[31], (bf16*)(ws + WS_W2IN_T), r, scr, F.lane); continue; } r -= I_FIN;
                transpose_plain(args.in[32], FF, D, (bf16*)(ws + WS_W2OUT_T), r, scr, F.lane);
            }
        }
    }
    SEAM(1);
    if (IN(2)) REPEAT(2) norm_phase(F, args.in[0], args.in[1], args.in[11], MOD_SH1, MOD_SC1);
    SEAM(2);
    if (IN(3)) REPEAT(3) { pg8::Gemm g{U, (const bf16*)(ws + WS_W1IN_T), M, 2 * FF, D, nullptr, nullptr}; pg8::StaticOrder S; S.init(M, 2 * FF, F.G, (int)blockIdx.x);
        pg8::EpiSwiglu E{HID}; pg8::gemm_phase<pg8::EpiSwiglu, pg8::StaticOrder, true, true>(F.lds + RING_OFF, g, S, E); }
    SEAM(3);
    if (IN(4)) { pg8::Gemm g{HID, (const bf16*)(ws + WS_W1OUT_T), NP, D, FF, nullptr, nullptr}; pg8::StaticOrder S; S.init(NP, D, F.G, (int)blockIdx.x);
        pg8::EpiResid E{args.in[0], args.in[1], H, MOD, MOD_G1, 0.5f}; REPEAT(4) pg8::gemm_phase<pg8::EpiResid, pg8::StaticOrder, true, true>(F.lds + RING_OFF, g, S, E);
        SEpiResid SE{args.in[1], H + (size_t)NP * D, MOD, MOD_G1, 0.5f}; REPEAT(16) sgemm_phase<SEpiResid, false>(F, HID, (const bf16*)(ws + WS_W1OUT_T), FF, nullptr, nullptr, 0, D, SE); }
    SEAM(4);
    if (IN(5)) REPEAT(5) norm_phase(F, H, H + (size_t)NP * D, args.in[14], MOD_SH2, MOD_SC2);
    SEAM(5);
    if (IN(6)) { pg8::Gemm g{U, (const bf16*)(ws + WS_WIN_T), NP, NIN, D, nullptr, nullptr}; pg8::StaticOrder S; S.init(NP, NIN, F.G, (int)blockIdx.x);
        pg8::EpiInproj E{(bf16*)(ws + WS_Q), (bf16*)(ws + WS_KB), (bf16*)(ws + WS_VB), (bf16*)(ws + WS_AU), (bf16*)(ws + WS_GA), (bf16*)(ws + WS_GB), F.out};
        REPEAT(6) pg8::gemm_phase<pg8::EpiInproj, pg8::StaticOrder, true, true>(F.lds + RING_OFF, g, S, E);
        SEpiInproj SE{(bf16*)(ws + WS_Q), (float*)(ws + WS_S), (bf16*)(ws + WS_GA), (bf16*)(ws + WS_GB), F.out}; REPEAT(17) sgemm128_phase<SEpiInproj>(F, U, (const bf16*)(ws + WS_WIN_T), D, NIN, SE); }
    SEAM(6);
    if (IN(7)) {
#ifndef P7_MASK
#define P7_MASK 7
#endif
        const int grp = F.vcu % 3;
#define P7_S() do { if (P7_MASK & 2) REPEAT(19) for (int ui = F.vcu; ui < 256; ui += F.G) sba::sample_unit(ui >> 1, ui & 1, (const bf16*)(ws + WS_Q), args.in[4], args.in[5], (const int*)args.in[8], F.out + O_KS + (size_t)(ui >> 1) * ST * 512, F.out + O_VS + (size_t)(ui >> 1) * ST * 512, args.in[16], (bf16*)(ws + WS_OA), (sba::lds_ptr)(F.lds + RING_OFF)); __syncthreads(); } while (0)
        if (grp == 0) P7_S();
        if (P7_MASK & 1) REPEAT(7) for (int pi = F.vcu; pi < 256; pi += F.G) { const int bh = pi >> 3, s = pi & 7, b = bh >> 3, h = bh & 7; const float bias2 = args.in[16][h] * LOG2E;
            sba::unit(b, h, 15 - s, (const bf16*)(ws + WS_Q), (const bf16*)(ws + WS_KB), (const bf16*)(ws + WS_VB), (bf16*)(ws + WS_OA), bias2, (sba::lds_ptr)(F.lds + RING_OFF));
            sba::unit(b, h, s, (const bf16*)(ws + WS_Q), (const bf16*)(ws + WS_KB), (const bf16*)(ws + WS_VB), (bf16*)(ws + WS_OA), bias2, (sba::lds_ptr)(F.lds + RING_OFF)); }
        __syncthreads();
        if (grp == 1) P7_S();
        if (P7_MASK & 4) REPEAT(20) { const int half = F.G >> 1;
            if (F.vcu < half) { for (int su = F.vcu; su < NGRP * PB; su += half) ssm_stage1_unit(F, SP, ST_, (const bf16*)(ws + WS_AU), (bf16*)(ws + WS_AC), su >> 2, su & 3); }
            else { for (int wu = F.vcu - half; wu < SB * 4; wu += F.G - half) ssm_scan_unit<true>(F, SP, wu >> 2, (wu & 3) * 8 + F.wave, 0); } }
        __syncthreads();
        if (grp == 2) P7_S();
#undef P7_S
    }
    SEAM(7);
    if (IN(8)) REPEAT(8) {
        for (int pu = F.vcu; pu < NGRP * PB * 4; pu += F.G) { const int gb = pu >> 2, j4 = pu & 3;
            ssm_stage2_unit(F, ST_, (const bf16*)(ws + WS_AU), (const bf16*)(ws + WS_AC), (bf16*)(ws + WS_ZG), gb >> 2, gb & 3, 7 - j4);
            ssm_stage2_unit(F, ST_, (const bf16*)(ws + WS_AU), (const bf16*)(ws + WS_AC), (bf16*)(ws + WS_ZG), gb >> 2, gb & 3, j4); } }
    SEAM(8);
    if (IN(9)) REPEAT(9) {
        pg8::Gemm g{(const bf16*)(ws + WS_ZG), (const bf16*)(ws + WS_GLU_T), M, HW, HW, (const bf16*)(ws + WS_OA), (const bf16*)(ws + WS_WA_T)};
        pg8::MixOrder S; S.init(M, HW, NP, D, F.G, (int)blockIdx.x);
        pg8::EpiGluBrA E{pg8::EpiGlu{(const bf16*)(ws + WS_ZG), (bf16*)(ws + WS_OB), args.in[26]}, pg8::EpiBranch{(const bf16*)(ws + WS_GA), (const bf16*)(ws + WS_GB), (float*)(ws + WS_TMP), (bf16*)(ws + WS_MRG)}};
        pg8::gemm_phase<pg8::EpiGluBrA, pg8::MixOrder, true, true>(F.lds + RING_OFF, g, S, E); }
    SEAM(9);
    if (IN(10)) { pg8::Gemm g{(const bf16*)(ws + WS_OA), (const bf16*)(ws + WS_WA_T), NP, D, HW, (const bf16*)(ws + WS_OB), (const bf16*)(ws + WS_WB_T)};
        pg8::EpiBranch E{(const bf16*)(ws + WS_GA), (const bf16*)(ws + WS_GB), (float*)(ws + WS_TMP), (bf16*)(ws + WS_MRG)};
        pg8::SelOrder S; S.init(NP, D, F.G, (int)blockIdx.x, 1); REPEAT(10) pg8::gemm_phase<pg8::EpiBranch, pg8::SelOrder, true, true>(F.lds + RING_OFF, g, S, E);
        SEpiBranch SE{(const bf16*)(ws + WS_GA), (const bf16*)(ws + WS_GB), (bf16*)(ws + WS_MRG)};
        REPEAT(18) sgemm_phase<SEpiBranch, true>(F, (const bf16*)(ws + WS_OA), (const bf16*)(ws + WS_WA_T), HW, (const bf16*)(ws + WS_OB), (const bf16*)(ws + WS_WB_T), HW, D, SE); }
    SEAM(10);
    if (IN(11)) { pg8::Gemm g{(const bf16*)(ws + WS_MRG), (const bf16*)(ws + WS_WOUT_T), NP, D, D, nullptr, nullptr}; pg8::StaticOrder S; S.init(NP, D, F.G, (int)blockIdx.x);
        pg8::EpiResid E{H, H + (size_t)NP * D, H, MOD, MOD_G2, 1.0f}; pg8::gemm_phase<pg8::EpiResid, pg8::StaticOrder, true, true>(F.lds + RING_OFF, g, S, E);
        SEpiResid SE{H + (size_t)NP * D, H + (size_t)NP * D, MOD, MOD_G2, 1.0f}; sgemm_phase<SEpiResid, false>(F, (const bf16*)(ws + WS_MRG), (const bf16*)(ws + WS_WOUT_T), D, nullptr, nullptr, 0, D, SE); }
    SEAM(11);
    if (IN(12)) REPEAT(12) norm_phase(F, H, H + (size_t)NP * D, args.in[30], MOD_SH3, MOD_SC3);
    SEAM(12);
    if (IN(13)) REPEAT(13) { pg8::Gemm g{U, (const bf16*)(ws + WS_W2IN_T), M, 2 * FF, D, nullptr, nullptr}; pg8::StaticOrder S; S.init(M, 2 * FF, F.G, (int)blockIdx.x);
        pg8::EpiSwiglu E{HID}; pg8::gemm_phase<pg8::EpiSwiglu, pg8::StaticOrder, true, true>(F.lds + RING_OFF, g, S, E); }
    SEAM(13);
    if (IN(14)) { pg8::Gemm g{HID, (const bf16*)(ws + WS_W2OUT_T), NP, D, FF, nullptr, nullptr}; pg8::StaticOrder S; S.init(NP, D, F.G, (int)blockIdx.x);
        pg8::EpiResid E{H, H + (size_t)NP * D, H, MOD, MOD_G3, 0.5f}; pg8::gemm_phase<pg8::EpiResid, pg8::StaticOrder, true, true>(F.lds + RING_OFF, g, S, E);
        SEpiResid SE{H + (size_t)NP * D, H + (size_t)NP * D, MOD, MOD_G3, 0.5f}; sgemm_phase<SEpiResid, false>(F, HID, (const bf16*)(ws + WS_W2OUT_T), FF, nullptr, nullptr, 0, D, SE); }
    SEAM(14);
#ifdef DBG_DUMP
    {
        const bf16* s0 = (const bf16*)(ws + (DBG_DUMP == 1 ? WS_ZG : DBG_DUMP == 2 ? WS_MRG : DBG_DUMP == 3 ? WS_U : DBG_DUMP == 4 ? WS_OA : WS_GA));
        const bf16* s1 = (const bf16*)(ws + (DBG_DUMP == 1 ? WS_OB : DBG_DUMP == 2 ? WS_MRG + (size_t)M * 1024 : DBG_DUMP == 3 ? WS_U + (size_t)M * 1024 : DBG_DUMP == 4 ? WS_OB : WS_GA + (size_t)M * 1024));
        const size_t n = (size_t)M * 512;
        for (size_t i = (size_t)blockIdx.x * 512 + F.tid; i < n; i += (size_t)F.G * 512) { F.out[i] = __builtin_bit_cast(float, (unsigned)s0[i] << 16); F.out[n + i] = __builtin_bit_cast(float, (unsigned)s1[i] << 16); }
    }
#endif
#ifdef EXTRA_BARRIERS
    for (int xb_ = 0; xb_ < EXTRA_BARRIERS; ++xb_) xcd_barrier(bar);
#endif
    if (IN(15)) REPEAT(15) {
        for (int m = gw; m < M; m += NGW) { const GAS f32x4* xr = (const GAS f32x4*)(H + (size_t)m * D) + F.lane; f32x4 v[4]; float s = 0.f;
#pragma unroll
            for (int j = 0; j < 4; ++j) { v[j] = xr[64 * j]; s += (v[j].x * v[j].x + v[j].y * v[j].y) + (v[j].z * v[j].z + v[j].w * v[j].w); }
            const float rs = 1.0f / sqrtf(wave_sum(s) * (1.f / D) + RMS_EPS);
            float* orow = F.out + (m < NP ? O_YP + (size_t)m * D : O_YS + (size_t)(m - NP) * D);
#pragma unroll
            for (int j = 0; j < 4; ++j) { const int c = 4 * F.lane + 256 * j; *(f32x4*)(orow + c) = v[j] * rs * *(const f32x4*)(args.in[33] + c); } }
    }
#undef IN
#undef SEAM
}

extern "C" void kernel_launch(void* const* d_in, const int* in_sizes, int n_in, void* d_out, int out_size, void* d_ws, size_t ws_size, hipStream_t stream) {
    static int grid = 0;
    if (grid == 0) {
        if (n_in != 34 || out_size != (int)O_TOTAL || ws_size < WS_TOTAL) { fprintf(stderr, "kernel_launch: unexpected shapes (n_in %d, out %d, ws %zu); nothing launched\n", n_in, out_size, ws_size); grid = -1; return; }
        int dev = 0, cus = 0, per_cu = 0;
        if (hipGetDevice(&dev) != hipSuccess || hipDeviceGetAttribute(&cus, hipDeviceAttributeMultiprocessorCount, dev) != hipSuccess) { grid = -1; return; }
        if (hipFuncSetAttribute((const void*)sbs5_fwd, hipFuncAttributeMaxDynamicSharedMemorySize, LDS_BYTES) != hipSuccess) { fprintf(stderr, "kernel_launch: hipFuncSetAttribute failed\n"); grid = -1; return; }
        if (hipOccupancyMaxActiveBlocksPerMultiprocessor(&per_cu, (const void*)sbs5_fwd, NWAVES * 64, LDS_BYTES) != hipSuccess || per_cu < 1) { fprintf(stderr, "kernel_launch: occupancy query reports %d workgroups per CU\n", per_cu); }
        (void)hipGetLastError();
        grid = cus;
    }
    if (grid < 0) return;
    (void)hipMemsetAsync((char*)d_ws + WS_CTL, 0, CTL_ZERO_BYTES, stream);
    Args a{};
    for (int i = 0; i < 34; ++i) a.in[i] = (const float*)d_in[i];
    a.out = (float*)d_out; a.ws = (unsigned char*)d_ws;
#if MK_PER_PHASE
    for (int ph = 0; ph < N_PHASES; ++ph) { a.ph_lo = ph; a.ph_hi = ph + 1; a.sub = 0; hipLaunchKernelGGL(sbs5_fwd, dim3(grid), dim3(NWAVES * 64), LDS_BYTES, stream, a); }
#else
    a.ph_lo = 0; a.ph_hi = N_PHASES; a.sub = -1; hipLaunchKernelGGL(sbs5_fwd, dim3(grid), dim3(NWAVES * 64), LDS_BYTES, stream, a);
#endif
    const hipError_t le = hipPeekAtLastError();
    if (le != hipSuccess) fprintf(stderr, "kernel_launch: launch failed: %s (grid %d)\n", hipGetErrorName(le), grid);
}
```
